# Optimizing an MI355X kernel written in HIP

```python
import numpy as np
import jax
import jax.numpy as jnp
from jax import lax

D_MODEL = 1024
BATCH = 4
SEQ = 4096
DEPTH = 2

D_MIX = D_MODEL
HEAD_DIM = 64
H_FOX = 6
FOX_W = H_FOX * HEAD_DIM
CONV_GROUPS = 4
CONV_W = CONV_GROUPS * HEAD_DIM
CONV_K = 3
H_MLA = 6
Q_LORA = 256
KV_LORA = 256
QK_NOPE = 64
QK_ROPE = 32
V_DIM = 64
MLA_W = H_MLA * V_DIM
N_OUT_HEADS = D_MIX // HEAD_DIM
IN_W = 3 * FOX_W + H_FOX + 3 * CONV_W + Q_LORA + KV_LORA + QK_ROPE
ROPE_THETA = 10000.0
Q_BLOCK = 128
D_FF = 2816
N_EXPERTS = 8
TOP_K = 2
D_EXPERT = 3584
MOE_BLOCK = 128
N_DENSE = (DEPTH + 1) // 2
N_MOE = DEPTH // 2
ALPHA = (2 * DEPTH) ** 0.25
BETA = (8 * DEPTH) ** -0.25
LN_EPS = 1e-5
RMS_EPS = 1e-6

kernel_name = 'hybrid_fox_conv_mla_deepnorm_moe'


def _layer_norm(x, g, b):
    xf = x.astype(jnp.float32)
    xc = xf - jnp.mean(xf, axis=-1, keepdims=True)
    var = jnp.mean(xc * xc, axis=-1, keepdims=True)
    return (xc * lax.rsqrt(var + LN_EPS) * g + b).astype(x.dtype)


def _rms_norm(x, g):
    xf = x.astype(jnp.float32)
    return (xf * lax.rsqrt(jnp.mean(xf * xf, axis=-1, keepdims=True) + RMS_EPS) * g).astype(x.dtype)


def _rope(x, cos, sin):
    xf = x.astype(jnp.float32)
    x1, x2 = jnp.split(xf, 2, axis=-1)
    return jnp.concatenate([x1 * cos - x2 * sin, x2 * cos + x1 * sin], axis=-1).astype(x.dtype)


def _block_causal_attention(q, k, v, log_decay=None):
    bsz, seq, nh, dk = q.shape
    nblk = seq // Q_BLOCK
    scale = dk ** -0.5
    key_pos = jnp.arange(seq)
    q_blocks = q.reshape(bsz, nblk, Q_BLOCK, nh, dk).transpose(1, 0, 2, 3, 4)
    xs = (q_blocks, jnp.arange(nblk))
    if log_decay is not None:
        fk = log_decay.transpose(0, 2, 1)
        xs = xs + (log_decay.reshape(bsz, nblk, Q_BLOCK, nh).transpose(1, 0, 2, 3),)

    def one_block(blk):
        qb, i = blk[0], blk[1]
        s = jnp.einsum('bqhd,bkhd->bhqk', qb, k, preferred_element_type=jnp.float32) * scale
        if log_decay is not None:
            s = s + blk[2].transpose(0, 2, 1)[..., None] - fk[:, :, None, :]
        q_pos = i * Q_BLOCK + jnp.arange(Q_BLOCK)
        s = jnp.where(key_pos[None, :] <= q_pos[:, None], s, -jnp.inf)
        p = jax.nn.softmax(s, axis=-1)
        return jnp.einsum('bhqk,bkhd->bqhd', p.astype(v.dtype), v)

    out = lax.map(one_block, xs)
    return out.transpose(1, 0, 2, 3, 4).reshape(bsz, seq, nh, v.shape[-1])


def _causal_depthwise_conv(u, w):
    return lax.conv_general_dilated(
        u, w[:, None, :], window_strides=(1,), padding=[(CONV_K - 1, 0)],
        dimension_numbers=('NWC', 'WIO', 'NWC'), feature_group_count=u.shape[-1])


def _hybrid_mixer(h, w_in, b_f, w_conv, q_g, kv_g, w_uq, w_ukv, head_g, w_o, cos, sin):
    bsz, seq, _ = h.shape
    z = h @ w_in
    sizes = [FOX_W, FOX_W, FOX_W, H_FOX, CONV_W, CONV_W, CONV_W, Q_LORA, KV_LORA, QK_ROPE]
    (fq, fk, fv, f_logit, b_gate, c_gate, h_in, c_q, c_kv, k_rope) = jnp.split(
        z, np.cumsum(sizes)[:-1].tolist(), axis=-1)

    log_f = jax.nn.log_sigmoid(f_logit.astype(jnp.float32) + b_f.astype(jnp.float32))
    cum_log_f = jnp.cumsum(log_f, axis=1)
    o_fox = _block_causal_attention(
        fq.reshape(bsz, seq, H_FOX, HEAD_DIM), fk.reshape(bsz, seq, H_FOX, HEAD_DIM),
        fv.reshape(bsz, seq, H_FOX, HEAD_DIM), cum_log_f)

    o_conv = b_gate * _causal_depthwise_conv(c_gate * h_in, w_conv)

    q = (_rms_norm(c_q, q_g) @ w_uq).reshape(bsz, seq, H_MLA, QK_NOPE + QK_ROPE)
    q = jnp.concatenate([q[..., :QK_NOPE], _rope(q[..., QK_NOPE:], cos[:, None, :], sin[:, None, :])], axis=-1)
    kv = (_rms_norm(c_kv, kv_g) @ w_ukv).reshape(bsz, seq, H_MLA, QK_NOPE + V_DIM)
    k_r = _rope(k_rope, cos, sin)
    k = jnp.concatenate(
        [kv[..., :QK_NOPE], jnp.broadcast_to(k_r[:, :, None, :], (bsz, seq, H_MLA, QK_ROPE))], axis=-1)
    o_mla = _block_causal_attention(q, k, kv[..., QK_NOPE:])

    o = jnp.concatenate(
        [o_fox.reshape(bsz, seq, FOX_W), o_conv, o_mla.reshape(bsz, seq, MLA_W)], axis=-1)
    o = _rms_norm(o.reshape(bsz, seq, N_OUT_HEADS, HEAD_DIM), head_g.reshape(N_OUT_HEADS, HEAD_DIM))
    return o.reshape(bsz, seq, D_MIX) @ w_o


def _swiglu(x, wg, wu, wd):
    return (jax.nn.silu(x @ wg) * (x @ wu)) @ wd


def _moe_swiglu(h, w_router, wg, wu, wd):
    bsz, seq, dm = h.shape
    n_tok = bsz * seq
    xf = h.reshape(n_tok, dm)
    logits = (xf @ w_router).astype(jnp.float32)
    top_logits, top_idx = lax.top_k(logits, TOP_K)
    top_w = jax.nn.softmax(top_logits, axis=-1)
    n_asg = n_tok * TOP_K
    e_flat = top_idx.reshape(n_asg)
    tok_flat = jnp.arange(n_asg) // TOP_K
    order = jnp.argsort(e_flat)
    sorted_e = e_flat[order]
    counts = jnp.bincount(e_flat, length=N_EXPERTS)
    padded = (counts + MOE_BLOCK - 1) // MOE_BLOCK * MOE_BLOCK
    pad_end = jnp.cumsum(padded)
    pad_start = pad_end - padded
    start = jnp.cumsum(counts) - counts
    dest_sorted = pad_start[sorted_e] + (jnp.arange(n_asg) - start[sorted_e])
    n_blocks = -(-n_asg // MOE_BLOCK) + N_EXPERTS
    n_rows = n_blocks * MOE_BLOCK
    row_tok = jnp.full((n_rows,), n_tok, dtype=jnp.int32).at[dest_sorted].set(tok_flat[order].astype(jnp.int32))
    x_rows = jnp.concatenate([xf, jnp.zeros((1, dm), xf.dtype)], axis=0)[row_tok]
    block_e = jnp.minimum(
        jnp.searchsorted(pad_end, jnp.arange(n_blocks) * MOE_BLOCK, side='right'), N_EXPERTS - 1)

    def expert_block(args):
        xb, e = args
        return _swiglu(xb, wg[e], wu[e], wd[e])

    y_rows = lax.map(expert_block, (x_rows.reshape(n_blocks, MOE_BLOCK, dm), block_e)).reshape(n_rows, dm)
    dest = jnp.zeros((n_asg,), dtype=dest_sorted.dtype).at[order].set(dest_sorted)
    y = y_rows[dest].reshape(n_tok, TOP_K, dm)
    out = jnp.einsum('tk,tkd->td', top_w.astype(y.dtype), y)
    return out.reshape(bsz, seq, dm)


def setup_inputs(seed: int = 0) -> dict:
    key = jax.random.key(seed)
    ks = jax.random.split(key, 24)

    def nrm(k, shape, scale):
        return jax.random.normal(k, shape, jnp.float32) * scale

    return {
        'x': nrm(ks[0], (BATCH, SEQ, D_MODEL), 1.0),
        'c': nrm(ks[1], (BATCH, D_MODEL), 1.0),
        'w_mod': nrm(ks[2], (DEPTH, D_MODEL, 6 * D_MODEL), 0.3 * D_MODEL ** -0.5),
        'b_mod': nrm(ks[3], (DEPTH, 6 * D_MODEL), 0.02),
        'w_in': nrm(ks[4], (DEPTH, D_MODEL, IN_W), D_MODEL ** -0.5),
        'b_fgate': jnp.linspace(1.0, 5.0, H_FOX, dtype=jnp.float32)[None, :] + nrm(ks[5], (DEPTH, H_FOX), 0.1),
        'w_conv': nrm(ks[6], (DEPTH, CONV_K, CONV_W), CONV_K ** -0.5),
        'q_norm_g': 1.0 + nrm(ks[7], (DEPTH, Q_LORA), 0.02),
        'kv_norm_g': 1.0 + nrm(ks[8], (DEPTH, KV_LORA), 0.02),
        'w_uq': nrm(ks[9], (DEPTH, Q_LORA, H_MLA * (QK_NOPE + QK_ROPE)), Q_LORA ** -0.5),
        'w_ukv': nrm(ks[10], (DEPTH, KV_LORA, H_MLA * (QK_NOPE + V_DIM)), KV_LORA ** -0.5),
        'head_norm_g': 1.0 + nrm(ks[11], (DEPTH, D_MIX), 0.02),
        'w_o': nrm(ks[12], (DEPTH, D_MIX, D_MODEL), BETA * D_MIX ** -0.5),
        'ln1_g': 1.0 + nrm(ks[13], (DEPTH, D_MODEL), 0.02),
        'ln1_b': nrm(ks[14], (DEPTH, D_MODEL), 0.02),
        'ln2_g': 1.0 + nrm(ks[15], (DEPTH, D_MODEL), 0.02),
        'ln2_b': nrm(ks[16], (DEPTH, D_MODEL), 0.02),
        'ffn_w_gate': nrm(ks[17], (N_DENSE, D_MODEL, D_FF), D_MODEL ** -0.5),
        'ffn_w_up': nrm(ks[18], (N_DENSE, D_MODEL, D_FF), D_MODEL ** -0.5),
        'ffn_w_down': nrm(ks[19], (N_DENSE, D_FF, D_MODEL), BETA * D_FF ** -0.5),
        'router_w': nrm(ks[20], (N_MOE, D_MODEL, N_EXPERTS), D_MODEL ** -0.5),
        'exp_w_gate': nrm(ks[21], (N_MOE, N_EXPERTS, D_MODEL, D_EXPERT), D_MODEL ** -0.5),
        'exp_w_up': nrm(ks[22], (N_MOE, N_EXPERTS, D_MODEL, D_EXPERT), D_MODEL ** -0.5),
        'exp_w_down': nrm(ks[23], (N_MOE, N_EXPERTS, D_EXPERT, D_MODEL), BETA * D_EXPERT ** -0.5),
    }


def reference(x, c, w_mod, b_mod, w_in, b_fgate, w_conv, q_norm_g, kv_norm_g, w_uq, w_ukv,
              head_norm_g, w_o, ln1_g, ln1_b, ln2_g, ln2_b, ffn_w_gate, ffn_w_up, ffn_w_down,
              router_w, exp_w_gate, exp_w_up, exp_w_down):
    seq = x.shape[1]
    pos = jnp.arange(seq, dtype=jnp.float32)
    inv_freq = ROPE_THETA ** (-jnp.arange(0, QK_ROPE, 2, dtype=jnp.float32) / QK_ROPE)
    ang = pos[:, None] * inv_freq[None, :]
    cos, sin = jnp.cos(ang), jnp.sin(ang)
    c_act = jax.nn.silu(c)
    for layer in range(DEPTH):
        mod = c_act @ w_mod[layer] + b_mod[layer]
        shift1, scale1, gate1, shift2, scale2, gate2 = [m[:, None, :] for m in jnp.split(mod, 6, axis=-1)]
        h = x * (1.0 + scale1) + shift1
        y = _hybrid_mixer(h, w_in[layer], b_fgate[layer], w_conv[layer], q_norm_g[layer],
                          kv_norm_g[layer], w_uq[layer], w_ukv[layer], head_norm_g[layer],
                          w_o[layer], cos, sin)
        x = _layer_norm(ALPHA * x + (1.0 + gate1) * y, ln1_g[layer], ln1_b[layer])
        h = x * (1.0 + scale2) + shift2
        j = layer // 2
        if layer % 2 == 0:
            y = _swiglu(h, ffn_w_gate[j], ffn_w_up[j], ffn_w_down[j])
        else:
            y = _moe_swiglu(h, router_w[j], exp_w_gate[j], exp_w_up[j], exp_w_down[j])
        x = _layer_norm(ALPHA * x + (1.0 + gate2) * y, ln2_g[layer], ln2_b[layer])
    return x
```

```cpp
#include <hip/hip_runtime.h>
#include <cstdio>
#include <cstdint>

#ifndef MK_N_LAUNCHES
#define MK_N_LAUNCHES 0
#endif

#ifndef PH_MASK
#define PH_MASK 0xFFF
#endif
#define PHM(k) ((PH_MASK >> (k)) & 1)
#define LAS __attribute__((address_space(3)))
typedef unsigned short bf16;
typedef short bf16x8 __attribute__((ext_vector_type(8)));
typedef short s16x4 __attribute__((ext_vector_type(4)));
typedef float f32x2 __attribute__((ext_vector_type(2)));
typedef float f32x4 __attribute__((ext_vector_type(4)));
typedef float f32x16 __attribute__((ext_vector_type(16)));
typedef unsigned u32x2 __attribute__((ext_vector_type(2)));
typedef unsigned u32x4 __attribute__((ext_vector_type(4)));
typedef __bf16 bf16x2_t __attribute__((ext_vector_type(2)));

constexpr int DM = 1024, NBATCH = 4, SEQ = 4096, T = NBATCH * SEQ;
constexpr int HF = 6, HM = 6;
constexpr int INW = 2470, INP = 2560;
constexpr int DFF = 2816, NE = 8, DEXP = 3584;
constexpr int NBLK = 256, NWAVES = 8;
constexpr float LOG2E = 1.4426950408889634f;
constexpr float C2F = 0.125f * LOG2E;
constexpr float C2M = 0.10206207261596575f * LOG2E;
constexpr float ALPHA = 1.4142135623730951f;
constexpr float LN_EPS = 1e-5f, RMS_EPS = 1e-6f;

constexpr size_t MiB = 1u << 20, KiB = 1024;
constexpr size_t WS_CTL = 0, CTL_ZERO_BYTES = 1 * MiB;
constexpr size_t WS_MOD = 1 * MiB;
constexpr size_t WS_CS = WS_MOD + 256 * KiB;
constexpr size_t WS_G = WS_CS + 512 * KiB;
constexpr size_t WS_LOGF = WS_G + 512 * KiB;
constexpr size_t WS_SSQ = WS_LOGF + 512 * KiB;
constexpr size_t WS_ROWL = WS_SSQ + 512 * KiB;
constexpr size_t WS_TOKP = WS_ROWL + 512 * KiB;
constexpr size_t WS_TOKW = WS_TOKP + 128 * KiB;
constexpr size_t WS_WEGU = 8 * MiB;
constexpr size_t WS_WED = 120 * MiB;
constexpr size_t WS_RA = 176 * MiB;
constexpr size_t WS_H = 240 * MiB;
constexpr size_t WS_R = 272 * MiB;
constexpr size_t WS_END = 498 * MiB;
constexpr size_t R_WIN = WS_R, R_WUQ = WS_R + 10 * MiB, R_WUKV = R_WUQ + 768 * KiB, R_WO = R_WUKV + 768 * KiB, R_WGU = R_WO + 4 * MiB, R_WD = R_WGU + 11 * MiB;
constexpr size_t R_Y = WS_R + 32 * MiB;
constexpr size_t R_CONV3 = WS_R + 32 * MiB, R_CQ = WS_R + 56 * MiB, R_CKV = WS_R + 64 * MiB, R_QM = WS_R + 72 * MiB, R_KVM = WS_R + 90 * MiB, R_OM = WS_R + 114 * MiB;
constexpr size_t R_FQ = WS_R + 146 * MiB, R_FK = WS_R + 158 * MiB, R_FV = WS_R + 170 * MiB, R_KR = WS_R + 182 * MiB;
constexpr size_t R_ACT = WS_R + 96 * MiB;
constexpr size_t R_ACTM = WS_R;
static_assert(R_WD + (size_t)DM * DFF * 2 <= R_Y, "weights fit");
static_assert(R_ACT + (size_t)T * DFF * 2 <= WS_END && R_ACTM + (size_t)(32768 + 256) * DEXP * 2 <= WS_END, "act fits");
constexpr int CW_BAR = 4096, CW_CNT = 8192, CW_AQ = 9216;

constexpr int RING_BYTES = 131072, MISC_OFF = RING_BYTES + 320, TAB_OFF = RING_BYTES + 1024, LDS_BYTES = 147456;

__device__ __forceinline__ unsigned pk2(float lo, float hi) { f32x2 v = {lo, hi}; bf16x2_t b = __builtin_convertvector(v, bf16x2_t); return __builtin_bit_cast(unsigned, b); }
__device__ __forceinline__ float bflo(unsigned u) { return __uint_as_float(u << 16); }
__device__ __forceinline__ float bfhi(unsigned u) { return __uint_as_float(u & 0xffff0000u); }
__device__ __forceinline__ float lane_get(float v, int src) { return __int_as_float(__builtin_amdgcn_ds_bpermute(src << 2, __float_as_int(v))); }
__device__ __forceinline__ float lane_xor(float v, int lane, int o) { return lane_get(v, lane ^ o); }
__device__ __forceinline__ float wave_sum(float v, int lane) {
#pragma unroll
    for (int o = 1; o < 64; o <<= 1) v += lane_xor(v, lane, o);
    return v;
}
#define LDS_WAIT() asm volatile("s_waitcnt lgkmcnt(0)" ::: "memory")
#define VM_WAIT() asm volatile("s_waitcnt vmcnt(0)" ::: "memory")
#define RLX_AGENT __ATOMIC_RELAXED, __HIP_MEMORY_SCOPE_AGENT

namespace g8 {
constexpr int BM = 256, BK = 64, HALF = 128, HTB = HALF * BK * 2, STAGE_BYTES = 8 * HTB, NXCD = 8, WGM = 8;
__host__ __device__ __forceinline__ int lds_byte(int r, int c) { const int st = (r >> 4) * 2 + (c >> 5), rr = r & 15, cc = c & 31, ob = rr * 64 + cc * 2; return st * 1024 + (ob ^ (((ob >> 9) & 1) << 5)); }
__host__ __device__ __forceinline__ void stage_rc(int b, int& R, int& C) { const int st = b / 1024, sb = b % 1024, swz = sb ^ (((sb >> 9) & 1) << 5); R = (st >> 1) * 16 + swz / 64; C = (st & 1) * 32 + (swz % 64) / 2; }
__host__ __device__ __forceinline__ int perm32(int rho) { const int n = rho >> 4, i = rho & 15; return 8 * (i >> 2) + 4 * n + (i & 3); }

struct Unit { int pm, pn, grp, mvalid, rowbase; const char* a; const char* b; const int* rl; };

__device__ __forceinline__ int xcd_remap(int wgid, int nwg) { const int q = nwg / NXCD, r = nwg % NXCD, xcd = wgid % NXCD, off = wgid / NXCD; return (xcd < r ? xcd * (q + 1) : r * (q + 1) + (xcd - r) * q) + off; }
__device__ __forceinline__ void grouped_pmpn(int local, int nM, int nN, int& pm, int& pn) {
    const int nig = WGM * nN, gid = local / nig, fm = gid * WGM, gsz = (nM - fm) < WGM ? (nM - fm) : WGM;
    pm = fm + ((local % nig) % gsz); pn = (local % nig) / gsz;
}
struct SchedPlain {
    const char* A; const char* Bt; int nM, nN, K, G, c;
    __device__ __forceinline__ bool next(int i, Unit& u) const {
        const int nwg = nM * nN; const long L = (long)i * G + c; if (L >= nwg) return false;
        const int wgid = xcd_remap((int)L, nwg); int pm, pn; grouped_pmpn(wgid, nM, nN, pm, pn);
        u.pm = pm; u.pn = pn; u.grp = 0; u.mvalid = 256; u.rowbase = pm * 256; u.a = A + (size_t)pm * 256 * K * 2; u.b = Bt + (size_t)pn * 256 * K * 2; u.rl = nullptr; return true;
    }
};
struct SchedPair {
    const char* A0; const char* B0; const char* A1; const char* B1; int nM, nN, K, G, c;
    __device__ __forceinline__ bool next(int i, Unit& u) const {
        const int per = nM * nN, nwg = 2 * per; const long L = (long)i * G + c; if (L >= nwg) return false;
        const int wgid = xcd_remap((int)L, nwg); const int grp = wgid / per; int pm, pn; grouped_pmpn(wgid % per, nM, nN, pm, pn);
        u.pm = pm; u.pn = pn; u.grp = grp; u.mvalid = 256; u.rowbase = pm * 256;
        u.a = (grp ? A1 : A0) + (size_t)pm * 256 * K * 2; u.b = (grp ? B1 : B0) + (size_t)pn * 256 * K * 2; u.rl = nullptr; return true;
    }
};
struct SchedMoE {
    const char* A; const char* Bt; size_t bexp; const int* rowl; volatile LAS int* tab; int nN, K, G, c; bool gather;
    __device__ __forceinline__ int tb(int i) const { return __builtin_amdgcn_readfirstlane(tab[i]); }
    __device__ __forceinline__ bool next(int i, Unit& u) const {
        const int nwg = tb(24); const long L = (long)i * G + c; if (L >= nwg) return false;
        const int wgid = xcd_remap((int)L, nwg);
        int e = 0;
#pragma unroll
        for (int j = 1; j < 8; ++j) if (wgid >= tb(16 + j)) e = j;
        const int local = wgid - tb(16 + e), nM = tb(25 + e), cnt = tb(e), start = tb(8 + e);
        int pm, pn; grouped_pmpn(local, nM, nN, pm, pn);
        u.pm = pm; u.pn = pn; u.grp = e; u.mvalid = (cnt - pm * 256) < 256 ? (cnt - pm * 256) : 256; u.rowbase = start + pm * 256;
        u.a = gather ? A : A + (size_t)(start + pm * 256) * K * 2; u.b = Bt + (size_t)e * bexp + (size_t)pn * 256 * K * 2; u.rl = rowl + e * 16384 + pm * 256; return true;
    }
};

template <class Epi, class Sched, bool GATHER>
__device__ __forceinline__ void gemm_phase(LAS unsigned char* lds, const int tid, const int K, const Sched& S, const Epi& E) {
    const int wid = __builtin_amdgcn_readfirstlane(tid >> 6), lane = tid & 63, wr = wid >> 2, wc = wid & 3, fr = lane & 15, fq = lane >> 4;
    const int nt = K / BK;
    int RA[2], CA[2]; unsigned voffB[2];
#pragma unroll
    for (int i = 0; i < 2; ++i) { int R, C; stage_rc(tid * 16 + i * 8192, R, C); const int Rb = Epi::PERM ? ((R & ~31) + perm32(R & 31)) : R; RA[i] = R; CA[i] = C; voffB[i] = (unsigned)(Rb * K + C) * 2u; }
    const size_t kstep = (size_t)(BK * 2);
    const size_t hstep = (size_t)HALF * K * 2;
    const unsigned ldsw = (unsigned)wid * 1024u;
    const int aoff = lds_byte(wr * 64 + fr, fq * 8), boff = lds_byte(wc * 32 + fr, fq * 8);
#define G8_SA(b, h) (((b) * 2 + (h)) * HTB)
#define G8_SB(b, h) ((4 + (b) * 2 + (h)) * HTB)
#define G8_STAGE_B(bufoff, gbase) do { _Pragma("unroll") for (int _i = 0; _i < 2; ++_i) \
        __builtin_amdgcn_global_load_lds((const unsigned*)((const char*)(gbase) + voffB[_i]), (LAS unsigned*)(lds + (bufoff) + ldsw + _i * 8192), 16, 0, 0); } while (0)
#define G8_STAGE_A(bufoff, gbase, AO, h) do { _Pragma("unroll") for (int _i = 0; _i < 2; ++_i) \
        __builtin_amdgcn_global_load_lds((const unsigned*)((const char*)(gbase) + AO[h][_i]), (LAS unsigned*)(lds + (bufoff) + ldsw + _i * 8192), 16, 0, 0); } while (0)
#define G8_LDA(dst, b, h) do { _Pragma("unroll") for (int m = 0; m < 4; ++m) _Pragma("unroll") for (int k = 0; k < 2; ++k) dst[m][k] = *(const LAS bf16x8*)(lds + G8_SA(b, h) + aoff + m * 2048 + k * 1024); } while (0)
#define G8_LDB(dst, b, h) do { _Pragma("unroll") for (int n = 0; n < 2; ++n) _Pragma("unroll") for (int k = 0; k < 2; ++k) dst[n][k] = *(const LAS bf16x8*)(lds + G8_SB(b, h) + boff + n * 2048 + k * 1024); } while (0)
#define G8_MMA(ai, bj, At, Bt) do { __builtin_amdgcn_s_setprio(1); _Pragma("unroll") for (int m = 0; m < 4; ++m) _Pragma("unroll") for (int n = 0; n < 2; ++n) _Pragma("unroll") for (int k = 0; k < 2; ++k) \
        acc[ai][bj][m][n] = __builtin_amdgcn_mfma_f32_16x16x32_bf16(Bt[n][k], At[m][k], acc[ai][bj][m][n], 0, 0, 0); __builtin_amdgcn_s_setprio(0); } while (0)
#define G8_WAIT_V(n) asm volatile("s_waitcnt vmcnt(" #n ")" ::: "memory")
#define G8_WAIT_L(n) asm volatile("s_waitcnt lgkmcnt(" #n ")" ::: "memory")
#define G8_BAR __builtin_amdgcn_s_barrier()
#define G8_SCHED __builtin_amdgcn_sched_barrier(0)
#define G8_AOFF(AO, U) do { _Pragma("unroll") for (int _h = 0; _h < 2; ++_h) _Pragma("unroll") for (int _i = 0; _i < 2; ++_i) { \
        if constexpr (GATHER) { const int _r = _h * HALF + RA[_i]; const int _tok = (_r < (U).mvalid) ? (U).rl[_r] : 0; AO[_h][_i] = (unsigned)_tok * (unsigned)(K * 2) + (unsigned)(CA[_i] * 2); } \
        else AO[_h][_i] = (unsigned)((_h * HALF + RA[_i]) * K + CA[_i]) * 2u; } } while (0)
    Unit cur, nxt; int ui = 0;
    if (!S.next(0, cur)) return;
    f32x4 acc[2][2][4][2];
#pragma unroll
    for (int a = 0; a < 2; ++a)
#pragma unroll
        for (int b = 0; b < 2; ++b)
#pragma unroll
            for (int m = 0; m < 4; ++m)
#pragma unroll
                for (int n = 0; n < 2; ++n) acc[a][b][m][n] = (f32x4){0.f, 0.f, 0.f, 0.f};
    bf16x8 At[4][2], B0[2][2], B1[2][2];
    unsigned aoc[2][2], aon[2][2];
    G8_AOFF(aoc, cur);
    if constexpr (GATHER) { VM_WAIT(); }
    const char* cA = cur.a; const char* cB = cur.b;
    G8_STAGE_B(G8_SB(0, 0), cB); G8_STAGE_B(G8_SB(0, 1), cB + hstep); G8_STAGE_A(G8_SA(0, 0), cA, aoc, 0); G8_STAGE_A(G8_SA(0, 1), cA, aoc, 1);
    if (wr == 1) G8_BAR;
    G8_WAIT_V(2); G8_BAR;
    G8_STAGE_B(G8_SB(1, 0), cB + kstep); G8_STAGE_A(G8_SA(1, 0), cA + kstep, aoc, 0); G8_STAGE_B(G8_SB(1, 1), cB + hstep + kstep);
    G8_WAIT_V(6); G8_BAR;
    for (;;) {
        const bool has_next = S.next(ui + 1, nxt);
        const char* nA = has_next ? nxt.a : cA; const char* nB = has_next ? nxt.b : cB;
        if constexpr (GATHER) {
            if (has_next) { G8_AOFF(aon, nxt); }
            else {
#pragma unroll
                for (int h = 0; h < 2; ++h)
#pragma unroll
                    for (int i = 0; i < 2; ++i) aon[h][i] = aoc[h][i];
            }
        }
#pragma unroll 1
        for (int t = 0; t < nt; t += 2) {
            const bool last = (t == nt - 2);
            const char* a1 = cA + (size_t)(t + 1) * kstep;
            const char* a2 = last ? nA : cA + (size_t)(t + 2) * kstep; const char* b2 = last ? nB : cB + (size_t)(t + 2) * kstep;
            const char* a3 = a2 + kstep; const char* b3 = b2 + kstep;
            unsigned ao2[2][2];
#pragma unroll
            for (int h = 0; h < 2; ++h)
#pragma unroll
                for (int i = 0; i < 2; ++i) { if constexpr (GATHER) ao2[h][i] = last ? aon[h][i] : aoc[h][i]; else ao2[h][i] = aoc[h][i]; }
            G8_LDB(B0, 0, 0); G8_LDB(B1, 0, 1); G8_SCHED; G8_LDA(At, 0, 0); G8_STAGE_A(G8_SA(1, 1), a1, aoc, 1);
            G8_WAIT_V(8); G8_WAIT_L(0); G8_BAR; G8_MMA(0, 0, At, B0); G8_MMA(0, 1, At, B1); G8_BAR; G8_SCHED;
            G8_LDA(At, 0, 1); G8_STAGE_B(G8_SB(0, 0), b2); G8_STAGE_B(G8_SB(0, 1), b2 + hstep); G8_STAGE_A(G8_SA(0, 0), a2, ao2, 0);
            G8_WAIT_V(8); G8_WAIT_L(0); G8_BAR; G8_MMA(1, 0, At, B0); G8_MMA(1, 1, At, B1); G8_BAR; G8_SCHED;
            G8_LDB(B0, 1, 0); G8_LDB(B1, 1, 1); G8_SCHED; G8_LDA(At, 1, 0); G8_STAGE_A(G8_SA(0, 1), a2, ao2, 1);
            G8_WAIT_V(8); G8_WAIT_L(0); G8_BAR; G8_MMA(0, 0, At, B0); G8_MMA(0, 1, At, B1); G8_BAR; G8_SCHED;
            G8_LDA(At, 1, 1); G8_STAGE_B(G8_SB(1, 0), b3); G8_STAGE_B(G8_SB(1, 1), b3 + hstep); G8_STAGE_A(G8_SA(1, 0), a3, ao2, 0);
            G8_WAIT_V(8); G8_WAIT_L(0); G8_BAR; G8_MMA(1, 0, At, B0); G8_MMA(1, 1, At, B1); G8_BAR; G8_SCHED;
        }
        if (wr == 0) G8_BAR;
        E(acc, cur, wr, wc, fr, fq);
        if (!has_next) break;
#pragma unroll
        for (int a = 0; a < 2; ++a)
#pragma unroll
            for (int b = 0; b < 2; ++b)
#pragma unroll
                for (int m = 0; m < 4; ++m)
#pragma unroll
                    for (int n = 0; n < 2; ++n) acc[a][b][m][n] = (f32x4){0.f, 0.f, 0.f, 0.f};
        cur = nxt; cA = nA; cB = nB; ++ui;
        if constexpr (GATHER) {
#pragma unroll
            for (int h = 0; h < 2; ++h)
#pragma unroll
                for (int i = 0; i < 2; ++i) aoc[h][i] = aon[h][i];
        }
        if (wr == 1) G8_BAR;
    }
    G8_WAIT_V(0);
    G8_BAR;
#undef G8_SA
#undef G8_SB
#undef G8_STAGE_A
#undef G8_STAGE_B
#undef G8_LDA
#undef G8_LDB
#undef G8_MMA
#undef G8_WAIT_V
#undef G8_WAIT_L
#undef G8_BAR
#undef G8_SCHED
#undef G8_AOFF
}

__device__ __forceinline__ float log_sigmoid(float x) { return fminf(x, 0.f) - log1pf(__expf(-fabsf(x))); }
__device__ __forceinline__ float silu_mul(float g, float u) { return g * u / (1.f + __expf(-g)); }

struct EpiIn {
    static constexpr bool PERM = true;
    bf16 *FQ, *FK, *FV, *KR, *CONV3, *CQ, *CKV; float* LOGF; float* SSQ; const float* bf; const f32x2* CS;
    __device__ __forceinline__ void operator()(const f32x4 (&acc)[2][2][4][2], const Unit& u, int wr, int wc, int fr, int fq) const {
        asm volatile("" : "+v"(fr), "+v"(fq));
        const int row0 = u.pm * 256 + wr * 64 + fr;
#pragma unroll
        for (int bj = 0; bj < 2; ++bj) {
            const int hb = 2 * u.pn + bj;
            if (hb == 9) {
                if (wc == 0) {
#pragma unroll
                    for (int ai = 0; ai < 2; ++ai)
#pragma unroll
                        for (int m = 0; m < 4; ++m) {
                            const int row = row0 + ai * 128 + m * 16, t = row & (SEQ - 1);
                            const f32x4 v0 = acc[ai][bj][m][0], v1 = acc[ai][bj][m][1];
                            const f32x4 c01 = *(const f32x4*)(CS + t * 16 + 4 * fq), c23 = *(const f32x4*)(CS + t * 16 + 4 * fq + 2);
                            u32x4 w;
                            w.x = pk2(v0[0] * c01[0] - v0[1] * c01[1], v0[1] * c01[0] + v0[0] * c01[1]);
                            w.y = pk2(v0[2] * c01[2] - v0[3] * c01[3], v0[3] * c01[2] + v0[2] * c01[3]);
                            w.z = pk2(v1[0] * c23[0] - v1[1] * c23[1], v1[1] * c23[0] + v1[0] * c23[1]);
                            w.w = pk2(v1[2] * c23[2] - v1[3] * c23[3], v1[3] * c23[2] + v1[2] * c23[3]);
                            *(u32x4*)(KR + (size_t)row * 32 + 8 * fq) = w;
                        }
                } else if (wc == 1) {
                    if (fq == 0) {
#pragma unroll
                        for (int ai = 0; ai < 2; ++ai)
#pragma unroll
                            for (int m = 0; m < 4; ++m) {
                                const int row = row0 + ai * 128 + m * 16;
                                const f32x4 v0 = acc[ai][bj][m][0], v1 = acc[ai][bj][m][1];
                                f32x4 o0, o1;
                                o0[0] = log_sigmoid(v0[0] + bf[0]); o0[1] = log_sigmoid(v0[1] + bf[1]); o0[2] = log_sigmoid(v0[2] + bf[2]); o0[3] = log_sigmoid(v0[3] + bf[3]);
                                o1[0] = log_sigmoid(v1[0] + bf[4]); o1[1] = log_sigmoid(v1[1] + bf[5]); o1[2] = 0.f; o1[3] = 0.f;
                                *(f32x4*)(LOGF + (size_t)row * 8) = o0; *(f32x4*)(LOGF + (size_t)row * 8 + 4) = o1;
                            }
                    }
                }
                continue;
            }
            bf16* base; int ld, colo; float sc = 1.f;
            if (hb < 3) { base = FQ; ld = 384; colo = 128 * hb; sc = C2F; }
            else if (hb < 6) { base = FK; ld = 384; colo = 128 * (hb - 3); }
            else if (hb < 9) { base = FV; ld = 384; colo = 128 * (hb - 6); }
            else if (hb < 16) { base = CONV3; ld = 768; colo = 128 * (hb - 10); }
            else if (hb < 18) { base = CQ; ld = 256; colo = 128 * (hb - 16); }
            else { base = CKV; ld = 256; colo = 128 * (hb - 18); }
            const int col = colo + wc * 32 + 8 * fq;
#pragma unroll
            for (int ai = 0; ai < 2; ++ai)
#pragma unroll
                for (int m = 0; m < 4; ++m) {
                    const int row = row0 + ai * 128 + m * 16;
                    const f32x4 v0 = acc[ai][bj][m][0] * sc, v1 = acc[ai][bj][m][1] * sc;
                    u32x4 w; w.x = pk2(v0[0], v0[1]); w.y = pk2(v0[2], v0[3]); w.z = pk2(v1[0], v1[1]); w.w = pk2(v1[2], v1[3]);
                    *(u32x4*)(base + (size_t)row * ld + col) = w;
                }
        }
        if (u.pn >= 8) {
            float* sq = SSQ + (size_t)(u.pn - 8) * T * 4;
#pragma unroll
            for (int ai = 0; ai < 2; ++ai)
#pragma unroll
                for (int m = 0; m < 4; ++m) {
                    float s = 0.f;
#pragma unroll
                    for (int bj = 0; bj < 2; ++bj)
#pragma unroll
                        for (int n = 0; n < 2; ++n) { const f32x4 x = acc[ai][bj][m][n]; s += (x[0] * x[0] + x[1] * x[1]) + (x[2] * x[2] + x[3] * x[3]); }
                    s += lane_xor(s, fq * 16 + fr, 16); s += lane_xor(s, fq * 16 + fr, 32);
                    if (fq == 0) sq[(size_t)(row0 + ai * 128 + m * 16) * 4 + wc] = s;
                }
        }
    }
};

template <int GRP> struct EpiUp {
    static constexpr bool PERM = true;
    bf16 *QM, *KVM; const float* SSQ; const f32x2* CS;
    __device__ __forceinline__ void operator()(const f32x4 (&acc)[2][2][4][2], const Unit& u, int wr, int wc, int fr, int fq) const {
        asm volatile("" : "+v"(fr), "+v"(fq));
        const int row0 = u.pm * 256 + wr * 64 + fr;
        const float* sq = SSQ + (size_t)GRP * T * 4;
#pragma unroll
        for (int ai = 0; ai < 2; ++ai)
#pragma unroll
            for (int m = 0; m < 4; ++m) {
                const int row = row0 + ai * 128 + m * 16, t = row & (SEQ - 1);
                const f32x4 p = *(const f32x4*)(sq + (size_t)row * 4);
                const float rstd = 1.0f / sqrtf(((p[0] + p[1]) + (p[2] + p[3])) * (1.f / 256.f) + RMS_EPS);
#pragma unroll
                for (int bj = 0; bj < 2; ++bj) {
                    const int col = u.pn * 256 + bj * 128 + wc * 32 + 8 * fq;
                    if (GRP == 0) {
                        if (col < 576) {
                            const float s = rstd * C2M;
                            f32x4 v0 = acc[ai][bj][m][0] * s, v1 = acc[ai][bj][m][1] * s;
                            const int j = col % 96;
                            if (j >= 64) {
                                const int pi = (j - 64) >> 1;
                                const f32x4 c01 = *(const f32x4*)(CS + t * 16 + pi), c23 = *(const f32x4*)(CS + t * 16 + pi + 2);
                                f32x4 r0, r1;
                                r0[0] = v0[0] * c01[0] - v0[1] * c01[1]; r0[1] = v0[1] * c01[0] + v0[0] * c01[1];
                                r0[2] = v0[2] * c01[2] - v0[3] * c01[3]; r0[3] = v0[3] * c01[2] + v0[2] * c01[3];
                                r1[0] = v1[0] * c23[0] - v1[1] * c23[1]; r1[1] = v1[1] * c23[0] + v1[0] * c23[1];
                                r1[2] = v1[2] * c23[2] - v1[3] * c23[3]; r1[3] = v1[3] * c23[2] + v1[2] * c23[3];
                                v0 = r0; v1 = r1;
                            }
                            u32x4 w; w.x = pk2(v0[0], v0[1]); w.y = pk2(v0[2], v0[3]); w.z = pk2(v1[0], v1[1]); w.w = pk2(v1[2], v1[3]);
                            *(u32x4*)(QM + (size_t)row * 576 + col) = w;
                        }
                    } else {
                        const f32x4 v0 = acc[ai][bj][m][0] * rstd, v1 = acc[ai][bj][m][1] * rstd;
                        u32x4 w; w.x = pk2(v0[0], v0[1]); w.y = pk2(v0[2], v0[3]); w.z = pk2(v1[0], v1[1]); w.w = pk2(v1[2], v1[3]);
                        *(u32x4*)(KVM + (size_t)row * 768 + col) = w;
                    }
                }
                asm volatile("" ::: "memory"); __builtin_amdgcn_sched_barrier(0);
            }
    }
};

struct EpiF32 {
    static constexpr bool PERM = false;
    float* Y; int ldc;
    __device__ __forceinline__ void operator()(const f32x4 (&acc)[2][2][4][2], const Unit& u, int wr, int wc, int fr, int fq) const {
        asm volatile("" : "+v"(fr), "+v"(fq));
        const int row0 = u.pm * 256 + wr * 64 + fr, col0 = u.pn * 256 + wc * 32 + 4 * fq;
#pragma unroll
        for (int ai = 0; ai < 2; ++ai)
#pragma unroll
            for (int m = 0; m < 4; ++m) { float* rp = Y + (size_t)(row0 + ai * 128 + m * 16) * ldc + col0;
#pragma unroll
                for (int bj = 0; bj < 2; ++bj)
#pragma unroll
                    for (int n = 0; n < 2; ++n) *(f32x4*)(rp + bj * 128 + n * 16) = acc[ai][bj][m][n]; }
    }
};

struct EpiSwiGLU {
    static constexpr bool PERM = true;
    bf16* ACT; int ld;
    __device__ __forceinline__ void operator()(const f32x4 (&acc)[2][2][4][2], const Unit& u, int wr, int wc, int fr, int fq) const {
        asm volatile("" : "+v"(fr), "+v"(fq));
        const int col = u.pn * 128 + wc * 32 + 8 * fq;
#pragma unroll
        for (int ai = 0; ai < 2; ++ai)
#pragma unroll
            for (int m = 0; m < 4; ++m) {
                const int rt = ai * 128 + wr * 64 + m * 16 + fr;
                if (rt < u.mvalid) {
                    const f32x4 g0 = acc[ai][0][m][0], g1 = acc[ai][0][m][1], u0 = acc[ai][1][m][0], u1 = acc[ai][1][m][1];
                    u32x4 w;
                    w.x = pk2(silu_mul(g0[0], u0[0]), silu_mul(g0[1], u0[1])); w.y = pk2(silu_mul(g0[2], u0[2]), silu_mul(g0[3], u0[3]));
                    w.z = pk2(silu_mul(g1[0], u1[0]), silu_mul(g1[1], u1[1])); w.w = pk2(silu_mul(g1[2], u1[2]), silu_mul(g1[3], u1[3]));
                    *(u32x4*)(ACT + (size_t)(u.rowbase + rt) * ld + col) = w;
                }
                asm volatile("" ::: "memory"); __builtin_amdgcn_sched_barrier(0);
            }
    }
};

struct EpiBf16Rows {
    static constexpr bool PERM = true;
    bf16* O; int ld;
    __device__ __forceinline__ void operator()(const f32x4 (&acc)[2][2][4][2], const Unit& u, int wr, int wc, int fr, int fq) const {
        asm volatile("" : "+v"(fr), "+v"(fq));
#pragma unroll
        for (int ai = 0; ai < 2; ++ai)
#pragma unroll
            for (int m = 0; m < 4; ++m) {
                const int rt = ai * 128 + wr * 64 + m * 16 + fr;
                if (rt < u.mvalid) {
#pragma unroll
                    for (int bj = 0; bj < 2; ++bj) {
                        const f32x4 v0 = acc[ai][bj][m][0], v1 = acc[ai][bj][m][1];
                        u32x4 w; w.x = pk2(v0[0], v0[1]); w.y = pk2(v0[2], v0[3]); w.z = pk2(v1[0], v1[1]); w.w = pk2(v1[2], v1[3]);
                        *(u32x4*)(O + (size_t)(u.rowbase + rt) * ld + u.pn * 256 + bj * 128 + wc * 32 + 8 * fq) = w;
                    }
                }
                asm volatile("" ::: "memory"); __builtin_amdgcn_sched_barrier(0);
            }
    }
};
}

#define XB_TMO      128
#define XB_XCNT(j)  (256  + 64 * (j))
#define XB_XSUB(j)  (1280 + 64 * (j))
#define XB_XGEN(j)  (2304 + 64 * (j))
#define XB_TOP      3328
#define XB_TOPGEN   3392
#define XCD_BAR_WORDS 3456
#define XB_SPIN_CAP (1u << 20)
__device__ __forceinline__ unsigned xb_ld(unsigned* p)              { return __hip_atomic_load(p, __ATOMIC_RELAXED, __HIP_MEMORY_SCOPE_AGENT); }
__device__ __forceinline__ unsigned xb_add(unsigned* p, unsigned v) { return __hip_atomic_fetch_add(p, v, __ATOMIC_RELAXED, __HIP_MEMORY_SCOPE_AGENT); }
__device__ __forceinline__ unsigned xb_xcc_id() { return (unsigned)__builtin_amdgcn_s_getreg((3 << 11) | 20) & 0xFu; }
#define XB_SPIN(cond, bar) do { unsigned _sp = 0; while (cond) { __builtin_amdgcn_s_sleep(1); \
    if ((++_sp & 255u) == 0u) { if (xb_ld(&(bar)[XB_TMO])) break; if (_sp > XB_SPIN_CAP) { atomicAdd(&(bar)[XB_TMO], 1u); break; } } } } while (0)
struct XcdBarrier { unsigned* bar; unsigned x; volatile LAS unsigned* st; };
__device__ __forceinline__ XcdBarrier xcd_barrier_post(unsigned* bar, volatile LAS unsigned* st) {
    XcdBarrier b; b.bar = bar; b.x = xb_xcc_id(); b.st = st;
    if (threadIdx.x == 0) (void)xb_add(&bar[XB_XCNT(b.x)], 1u);
    return b;
}
__device__ __forceinline__ void xcd_barrier_complete(unsigned* bar, unsigned x, unsigned& nloc, unsigned& nx) {
    const unsigned G = gridDim.x * gridDim.y * gridDim.z;
    unsigned sum, cnt, mine, sp = 0u;
    for (;;) {
        sum = 0u; cnt = 0u; mine = 0u;
#pragma unroll
        for (unsigned j = 0; j < 16; ++j) { const unsigned c = xb_ld(&bar[XB_XCNT(j)]); sum += c; cnt += (c > 0u) ? 1u : 0u; mine = (j == x) ? c : mine; }
        if (sum == G) break;
        __builtin_amdgcn_s_sleep(1);
        if ((++sp & 255u) == 0u) { if (xb_ld(&bar[XB_TMO])) break; if (sp > XB_SPIN_CAP) { atomicAdd(&bar[XB_TMO], 1u); break; } }
    }
    nloc = mine > 0u ? mine : 1u; nx = cnt > 0u ? cnt : 1u;
}
__device__ __forceinline__ void xcd_barrier(const XcdBarrier& b) {
    asm volatile("s_waitcnt vmcnt(0)" ::: "memory");
    __syncthreads();
    if (threadIdx.x == 0) {
        unsigned* bar = b.bar;
        __builtin_amdgcn_s_waitcnt(0);
        unsigned nloc = b.st[0], nx = b.st[1];
        if (nloc == 0u) { xcd_barrier_complete(bar, b.x, nloc, nx); b.st[0] = nloc; b.st[1] = nx; }
        const unsigned old = xb_add(&bar[XB_XSUB(b.x)], 1u);
        const unsigned gen = old / nloc;
        if (old + 1u == (gen + 1u) * nloc) {
            __builtin_amdgcn_fence(__ATOMIC_RELEASE, "agent");
            asm volatile("s_waitcnt vmcnt(0)" ::: "memory");
            const unsigned og = xb_add(&bar[XB_TOP], 1u);
            const unsigned tg = og / nx;
            if (og + 1u == (tg + 1u) * nx) xb_add(&bar[XB_TOPGEN], 1u);
            else XB_SPIN(xb_ld(&bar[XB_TOPGEN]) == tg, bar);
            __builtin_amdgcn_fence(__ATOMIC_ACQUIRE, "agent");
            xb_add(&bar[XB_XGEN(b.x)], 1u);
            asm volatile("s_waitcnt vmcnt(0)" ::: "memory");
        } else {
            XB_SPIN(xb_ld(&bar[XB_XGEN(b.x)]) == gen, bar);
            __builtin_amdgcn_fence(__ATOMIC_ACQUIRE, "agent");
            asm volatile("s_waitcnt vmcnt(0)" ::: "memory");
        }
    }
    __syncthreads();
}

struct Args { const float* in[24]; float* out; unsigned char* ws; int ph_lo, ph_hi; };
enum { I_X = 0, I_C, I_WMOD, I_BMOD, I_WIN, I_BF, I_WCONV, I_QG, I_KVG, I_WUQ, I_WUKV, I_HG, I_WO, I_LN1G, I_LN1B, I_LN2G, I_LN2B, I_FWG, I_FWU, I_FWD, I_RW, I_EWG, I_EWU, I_EWD };

struct Ctx {
    LAS unsigned char* lds; volatile LAS unsigned* MISC; volatile LAS int* TAB;
    unsigned* ctl; unsigned char* ws; const float* const* in; float* out;
    int tid, lane, wave, vcu;
};

__device__ __forceinline__ void transpose_item(const Ctx& F, const float* W, int Nsrc, int srccol, int k0, const float* kscale, bf16* dst, int dstK, int n0) {
    LAS float* s = (LAS float*)(F.lds + F.wave * 16640);
    const float mask = srccol >= 0 ? 1.f : 0.f; const int sc = srccol >= 0 ? srccol : 0;
    const float* src = W + (size_t)k0 * Nsrc + sc;
#pragma unroll 16
    for (int kk = 0; kk < 64; ++kk) s[kk * 65 + F.lane] = src[(size_t)kk * Nsrc] * mask;
    LDS_WAIT(); asm volatile("" ::: "memory");
    const int c = F.lane >> 3, nl = F.lane & 7;
    f32x4 ks0 = {1.f, 1.f, 1.f, 1.f}, ks1 = {1.f, 1.f, 1.f, 1.f};
    if (kscale) { ks0 = *(const f32x4*)(kscale + k0 + 8 * c); ks1 = *(const f32x4*)(kscale + k0 + 8 * c + 4); }
#pragma unroll
    for (int j = 0; j < 8; ++j) {
        const int n = nl + 8 * j; const LAS float* p = s + (8 * c) * 65 + n;
        u32x4 o; o.x = pk2(p[0] * ks0[0], p[65] * ks0[1]); o.y = pk2(p[130] * ks0[2], p[195] * ks0[3]); o.z = pk2(p[260] * ks1[0], p[325] * ks1[1]); o.w = pk2(p[390] * ks1[2], p[455] * ks1[3]);
        *(u32x4*)(dst + (size_t)(n0 + n) * dstK + k0 + 8 * c) = o;
    }
    LDS_WAIT(); asm volatile("" ::: "memory");
}

__device__ __forceinline__ void p0a(const Ctx& F) {
    const float* const* in = F.in;
    if ((int)blockIdx.x < 48) {
        const int l = blockIdx.x / 24, col0 = (blockIdx.x % 24) * 256;
        const float* c = in[I_C]; const float* wm = in[I_WMOD] + (size_t)l * 1024 * 6144;
        float sc[4][2];
#pragma unroll
        for (int b = 0; b < 4; ++b)
#pragma unroll
            for (int j = 0; j < 2; ++j) { const float v = c[b * 1024 + F.wave * 128 + j * 64 + F.lane]; sc[b][j] = v / (1.f + __expf(-v)); }
        f32x4 acc[4];
#pragma unroll
        for (int b = 0; b < 4; ++b) acc[b] = (f32x4){0.f, 0.f, 0.f, 0.f};
#pragma unroll
        for (int j = 0; j < 2; ++j) {
#pragma unroll 8
            for (int kk = 0; kk < 64; ++kk) {
                const f32x4 w4 = *(const f32x4*)(wm + (size_t)(F.wave * 128 + j * 64 + kk) * 6144 + col0 + 4 * F.lane);
#pragma unroll
                for (int b = 0; b < 4; ++b) { const float sv = lane_get(sc[b][j], kk); acc[b] += w4 * sv; }
            }
        }
        LAS float* red = (LAS float*)F.lds;
#pragma unroll
        for (int b = 0; b < 4; ++b) *(LAS f32x4*)(red + (F.wave * 4 + b) * 256 + 4 * F.lane) = acc[b];
        __syncthreads();
        float* MOD = (float*)(F.ws + WS_MOD);
        for (int idx = F.tid; idx < 1024; idx += 512) {
            const int b = idx >> 8, col = idx & 255; float s = in[I_BMOD][l * 6144 + col0 + col];
#pragma unroll
            for (int w = 0; w < 8; ++w) s += red[(w * 4 + b) * 256 + col];
            MOD[(size_t)(l * 4 + b) * 6144 + col0 + col] = s;
        }
        __syncthreads();
    }
    {
        const int idx = blockIdx.x * 512 + F.tid;
        if (idx < SEQ * 16) {
            const int pos = idx >> 4, i = idx & 15;
            double inv = 1.0; for (int j = 0; j < i; ++j) inv *= 0.56234132519034908039;
            const double ang = (double)pos * inv;
            const double TWO_PI_HI = 6.283185307179586232, TWO_PI_LO = 2.4492935982947064e-16;
            const double n = __builtin_rint(ang * 0.15915494309189533577);
            double r = __builtin_fma(-n, TWO_PI_HI, ang); r = __builtin_fma(-n, TWO_PI_LO, r);
            const double r2 = r * r; double sn = r, cs = 1.0, ts = r, tc = 1.0;
            for (int k = 1; k <= 14; ++k) { tc = -tc * r2 / (double)((2 * k - 1) * (2 * k)); cs += tc; ts = -ts * r2 / (double)((2 * k) * (2 * k + 1)); sn += ts; }
            ((f32x2*)(F.ws + WS_CS))[idx] = (f32x2){(float)cs, (float)sn};
        }
    }
    const int gw = F.vcu * NWAVES + F.wave, NGW = NBLK * NWAVES;
    for (int it = gw; it < 25600; it += NGW) {
        if (it < 1984) {
            const int l = it / 992; int r = it % 992;
            if (r < 640) {
                const int kb = r / 40, nb = r % 40, np = nb * 64 + F.lane; int sc;
                if (np < 1152) sc = np; else if (np < 1184) { const int i = np - 1152; sc = 2438 + (i >> 1) + 16 * (i & 1); } else if (np < 1190) sc = 1152 + (np - 1184); else if (np < 1280) sc = -1; else sc = 1158 + (np - 1280);
                transpose_item(F, in[I_WIN] + (size_t)l * 1024 * INW, INW, sc, kb * 64, nullptr, (bf16*)(F.ws + R_WIN) + (size_t)l * INP * 1024, 1024, nb * 64);
            } else if (r < 688) {
                r -= 640; const int kb = r / 12, nb = r % 12, np = nb * 64 + F.lane; int sc = -1;
                if (np < 576) { const int hh = np / 96, j = np % 96; if (j < 64) sc = hh * 96 + j; else { const int i = j - 64; sc = hh * 96 + 64 + (i >> 1) + 16 * (i & 1); } }
                transpose_item(F, in[I_WUQ] + (size_t)l * 256 * 576, 576, sc, kb * 64, in[I_QG] + l * 256, (bf16*)(F.ws + R_WUQ) + (size_t)l * 768 * 256, 256, nb * 64);
            } else if (r < 736) {
                r -= 688; const int kb = r / 12, nb = r % 12;
                transpose_item(F, in[I_WUKV] + (size_t)l * 256 * 768, 768, nb * 64 + F.lane, kb * 64, in[I_KVG] + l * 256, (bf16*)(F.ws + R_WUKV) + (size_t)l * 768 * 256, 256, nb * 64);
            } else {
                r -= 736; const int kb = r / 16, nb = r % 16;
                transpose_item(F, in[I_WO] + (size_t)l * 1024 * 1024, 1024, nb * 64 + F.lane, kb * 64, in[I_HG] + l * 1024, (bf16*)(F.ws + R_WO) + (size_t)l * 1024 * 1024, 1024, nb * 64);
            }
        } else if (it < 3392) {
            const int r = it - 1984, kb = r / 88, nb = r % 88, n0 = nb * 64, pn = n0 >> 8, j0 = n0 & 255;
            const float* W = j0 < 128 ? in[I_FWG] : in[I_FWU];
            transpose_item(F, W, DFF, pn * 128 + (j0 & 127) + F.lane, kb * 64, nullptr, (bf16*)(F.ws + R_WGU), 1024, n0);
        } else if (it < 4096) {
            const int r = it - 3392, kb = r / 16, nb = r % 16;
            transpose_item(F, in[I_FWD], 1024, nb * 64 + F.lane, kb * 64, nullptr, (bf16*)(F.ws + R_WD), DFF, nb * 64);
        } else {
            int r = it - 4096; const int e = r / 2688; r %= 2688;
            if (r < 1792) {
                const int kb = r / 112, nb = r % 112, n0 = nb * 64, pn = n0 >> 8, j0 = n0 & 255;
                const float* W = (j0 < 128 ? in[I_EWG] : in[I_EWU]) + (size_t)e * 1024 * DEXP;
                transpose_item(F, W, DEXP, pn * 128 + (j0 & 127) + F.lane, kb * 64, nullptr, (bf16*)(F.ws + WS_WEGU) + (size_t)e * 7168 * 1024, 1024, n0);
            } else {
                r -= 1792; const int kb = r / 16, nb = r % 16;
                transpose_item(F, in[I_EWD] + (size_t)e * DEXP * 1024, 1024, nb * 64 + F.lane, kb * 64, nullptr, (bf16*)(F.ws + WS_WED) + (size_t)e * 1024 * DEXP, DEXP, nb * 64);
            }
        }
    }
}

template <int MODE>
__device__ __forceinline__ void row_phase(const Ctx& F, int l, bool moe) {
    const float* MOD = (const float*)(F.ws + WS_MOD);
    const float* Y = (const float*)(F.ws + R_Y);
    float* RA = (float*)(F.ws + WS_RA);
    bf16* H = (bf16*)(F.ws + WS_H);
    volatile LAS int* lcnt = (volatile LAS int*)(F.lds);
    LAS int* rec = (LAS int*)(F.lds + 256);
    LAS float* recw = (LAS float*)(F.lds + 256 + 1024);
    const int rowb = blockIdx.x * 64;
    int start[8];
    if (MODE == 1 && moe) { if (F.tid < 16) lcnt[F.tid] = 0; __syncthreads(); }
    if (MODE == 2 && moe) { int s = 0;
#pragma unroll
        for (int e = 0; e < 8; ++e) { start[e] = s; s += (int)__hip_atomic_load(F.ctl + CW_CNT + 64 * e, RLX_AGENT); } }
    for (int rr = 0; rr < 8; ++rr) {
        const int rl = F.wave * 8 + rr, row = rowb + rl, b = row >> 12;
        const float* modb = MOD + (size_t)(l * 4 + b) * 6144;
        f32x4 v[4];
        if (MODE == 0) {
#pragma unroll
            for (int j = 0; j < 4; ++j) { const int c = 4 * F.lane + 256 * j; const f32x4 x = *(const f32x4*)(F.in[I_X] + (size_t)row * 1024 + c);
                const f32x4 sc = *(const f32x4*)(modb + 1024 + c), sh = *(const f32x4*)(modb + c); v[j] = x * (sc + 1.f) + sh; }
        } else {
            const float* res = MODE == 1 ? (l == 0 ? F.in[I_X] : F.out) : RA;
            const float* gate = modb + (MODE == 1 ? 2 : 5) * 1024;
            const float* lg = F.in[MODE == 1 ? I_LN1G : I_LN2G] + l * 1024; const float* lb = F.in[MODE == 1 ? I_LN1B : I_LN2B] + l * 1024;
            f32x4 y[4];
            if (MODE == 2 && moe) {
                const int p0 = ((const int*)(F.ws + WS_TOKP))[row * 2], p1 = ((const int*)(F.ws + WS_TOKP))[row * 2 + 1];
                const float w0 = ((const float*)(F.ws + WS_TOKW))[row * 2], w1 = ((const float*)(F.ws + WS_TOKW))[row * 2 + 1];
                const bf16* YR = (const bf16*)(F.ws + WS_WEGU);
                const size_t r0 = (size_t)(start[p0 >> 14] + (p0 & 16383)), r1 = (size_t)(start[p1 >> 14] + (p1 & 16383));
#pragma unroll
                for (int j = 0; j < 4; ++j) { const int c = 4 * F.lane + 256 * j; const u32x2 a = *(const u32x2*)(YR + r0 * 1024 + c), bq = *(const u32x2*)(YR + r1 * 1024 + c);
                    y[j] = (f32x4){bflo(a.x), bfhi(a.x), bflo(a.y), bfhi(a.y)} * w0 + (f32x4){bflo(bq.x), bfhi(bq.x), bflo(bq.y), bfhi(bq.y)} * w1; }
            } else {
#pragma unroll
                for (int j = 0; j < 4; ++j) y[j] = *(const f32x4*)(Y + (size_t)row * 1024 + 4 * F.lane + 256 * j);
            }
            float s = 0.f;
#pragma unroll
            for (int j = 0; j < 4; ++j) { const int c = 4 * F.lane + 256 * j; const f32x4 r4 = *(const f32x4*)(res + (size_t)row * 1024 + c), g4 = *(const f32x4*)(gate + c);
                v[j] = r4 * ALPHA + (g4 + 1.f) * y[j]; s += (v[j][0] + v[j][1]) + (v[j][2] + v[j][3]); }
            const float mean = wave_sum(s, F.lane) * (1.f / 1024.f); float q = 0.f;
#pragma unroll
            for (int j = 0; j < 4; ++j) { v[j] = v[j] - mean; q += (v[j][0] * v[j][0] + v[j][1] * v[j][1]) + (v[j][2] * v[j][2] + v[j][3] * v[j][3]); }
            const float rstd = 1.0f / sqrtf(wave_sum(q, F.lane) * (1.f / 1024.f) + LN_EPS);
            float* xo = MODE == 1 ? RA : F.out;
#pragma unroll
            for (int j = 0; j < 4; ++j) { const int c = 4 * F.lane + 256 * j; const f32x4 g4 = *(const f32x4*)(lg + c), b4 = *(const f32x4*)(lb + c);
                v[j] = v[j] * rstd * g4 + b4; *(f32x4*)(xo + (size_t)row * 1024 + c) = v[j]; }
            if (MODE == 2 && l == 1) continue;
            const float* modn = MODE == 1 ? modb + 3 * 1024 : MOD + (size_t)((l + 1) * 4 + b) * 6144;
#pragma unroll
            for (int j = 0; j < 4; ++j) { const int c = 4 * F.lane + 256 * j; const f32x4 sc = *(const f32x4*)(modn + 1024 + c), sh = *(const f32x4*)(modn + c); v[j] = v[j] * (sc + 1.f) + sh; }
        }
#pragma unroll
        for (int j = 0; j < 4; ++j) { u32x2 w; w.x = pk2(v[j][0], v[j][1]); w.y = pk2(v[j][2], v[j][3]); *(u32x2*)(H + (size_t)row * 1024 + 4 * F.lane + 256 * j) = w; }
        if (MODE == 1 && moe) {
            const float* rw = F.in[I_RW];
            float lg8[8];
#pragma unroll
            for (int e = 0; e < 8; ++e) lg8[e] = 0.f;
#pragma unroll
            for (int j = 0; j < 4; ++j)
#pragma unroll
                for (int i = 0; i < 4; ++i) { const int c = 4 * F.lane + 256 * j + i; const f32x4 wa = *(const f32x4*)(rw + (size_t)c * 8), wb = *(const f32x4*)(rw + (size_t)c * 8 + 4); const float hv = v[j][i];
                    lg8[0] += hv * wa[0]; lg8[1] += hv * wa[1]; lg8[2] += hv * wa[2]; lg8[3] += hv * wa[3]; lg8[4] += hv * wb[0]; lg8[5] += hv * wb[1]; lg8[6] += hv * wb[2]; lg8[7] += hv * wb[3]; }
#pragma unroll
            for (int e = 0; e < 8; ++e) lg8[e] = wave_sum(lg8[e], F.lane);
            int e0 = 0; float m0 = lg8[0];
#pragma unroll
            for (int e = 1; e < 8; ++e) if (lg8[e] > m0) { m0 = lg8[e]; e0 = e; }
            int e1 = -1; float m1 = -INFINITY;
#pragma unroll
            for (int e = 0; e < 8; ++e) if (e != e0 && lg8[e] > m1) { m1 = lg8[e]; e1 = e; }
            if (F.lane == 0) {
                const float ex = __expf(m1 - m0), w0 = 1.f / (1.f + ex), w1 = ex / (1.f + ex);
                const int k0 = __hip_atomic_fetch_add((LAS int*)(F.lds) + e0, 1, __ATOMIC_RELAXED, __HIP_MEMORY_SCOPE_WORKGROUP);
                const int k1 = __hip_atomic_fetch_add((LAS int*)(F.lds) + e1, 1, __ATOMIC_RELAXED, __HIP_MEMORY_SCOPE_WORKGROUP);
                rec[rl * 4 + 0] = e0; rec[rl * 4 + 1] = e1; rec[rl * 4 + 2] = k0; rec[rl * 4 + 3] = k1; recw[rl * 2] = w0; recw[rl * 2 + 1] = w1;
            }
        }
    }
    if (MODE == 1 && moe) {
        __syncthreads();
        if (F.tid < 8) lcnt[8 + F.tid] = (int)__hip_atomic_fetch_add(F.ctl + CW_CNT + 64 * F.tid, (unsigned)lcnt[F.tid], RLX_AGENT);
        __syncthreads();
        if (F.tid < 128) {
            const int rl = F.tid >> 1, k = F.tid & 1, e = rec[rl * 4 + k], pos = lcnt[8 + e] + rec[rl * 4 + 2 + k], row = rowb + rl;
            ((int*)(F.ws + WS_ROWL))[e * 16384 + pos] = row;
            ((int*)(F.ws + WS_TOKP))[row * 2 + k] = e * 16384 + pos;
            ((float*)(F.ws + WS_TOKW))[row * 2 + k] = recw[rl * 2 + k];
        }
        __syncthreads();
    }
}

__device__ __forceinline__ void scan_conv(const Ctx& F, int l) {
    const int gw = F.vcu * NWAVES + F.wave, NGW = NBLK * NWAVES;
    if (gw < 24) {
        const int b = gw / 6, h = gw % 6; const float* LOGF = (const float*)(F.ws + WS_LOGF); float* G = (float*)(F.ws + WS_G) + (size_t)gw * SEQ;
        float carry = 0.f;
        for (int j = 0; j < 64; ++j) {
            float v = LOGF[(size_t)(b * SEQ + j * 64 + F.lane) * 8 + h];
#pragma unroll
            for (int o = 1; o < 64; o <<= 1) { const float t = lane_get(v, F.lane - o); if (F.lane >= o) v += t; }
            v += carry; carry = lane_get(v, 63);
            G[j * 64 + F.lane] = -v * LOG2E;
        }
    }
    const bf16* C3 = (const bf16*)(F.ws + R_CONV3); bf16* OM = (bf16*)(F.ws + R_OM);
    const float* wc = F.in[I_WCONV] + l * 3 * 256;
    const f32x4 w0 = *(const f32x4*)(wc + 4 * F.lane), w1 = *(const f32x4*)(wc + 256 + 4 * F.lane), w2 = *(const f32x4*)(wc + 512 + 4 * F.lane);
    for (int m = gw; m < T; m += NGW) {
        const int t = m & (SEQ - 1);
        f32x4 cv = {0.f, 0.f, 0.f, 0.f};
#pragma unroll
        for (int d = 0; d < 3; ++d) {
            if (t - d >= 0) {
                const bf16* rp = C3 + (size_t)(m - d) * 768 + 4 * F.lane;
                const u32x2 cg = *(const u32x2*)(rp + 256), hi = *(const u32x2*)(rp + 512);
                const f32x4 u = (f32x4){bflo(cg.x) * bflo(hi.x), bfhi(cg.x) * bfhi(hi.x), bflo(cg.y) * bflo(hi.y), bfhi(cg.y) * bfhi(hi.y)};
                cv += u * (d == 0 ? w2 : (d == 1 ? w1 : w0));
            }
        }
        const u32x2 bg = *(const u32x2*)(C3 + (size_t)m * 768 + 4 * F.lane);
        f32x4 o = cv * (f32x4){bflo(bg.x), bfhi(bg.x), bflo(bg.y), bfhi(bg.y)};
        float s = (o[0] * o[0] + o[1] * o[1]) + (o[2] * o[2] + o[3] * o[3]);
        s += lane_xor(s, F.lane, 1); s += lane_xor(s, F.lane, 2); s += lane_xor(s, F.lane, 4); s += lane_xor(s, F.lane, 8);
        const float rstd = 1.0f / sqrtf(s * (1.f / 64.f) + RMS_EPS);
        o = o * rstd; u32x2 w; w.x = pk2(o[0], o[1]); w.y = pk2(o[2], o[3]);
        *(u32x2*)(OM + (size_t)m * 1024 + 384 + 4 * F.lane) = w;
    }
}

namespace att {
typedef short v4i16_t __attribute__((ext_vector_type(4)));
constexpr int KB0 = 0, KBSZ = 12288, VB0 = 2 * KBSZ, VBSZ = 8192, GB0 = VB0 + 2 * VBSZ, WSF0 = GB0 + 512, OST0 = WSF0 + 2048;
static_assert(OST0 + 8 * 8192 <= RING_BYTES, "attention LDS");
__device__ __forceinline__ int crow(int r, int hi) { return (r & 3) + 8 * (r >> 2) + 4 * hi; }
__device__ __forceinline__ s16x4 vtr(const LAS unsigned char* p) { return __builtin_bit_cast(s16x4, __builtin_amdgcn_ds_read_tr16_b64_v4i16((LAS v4i16_t*)p)); }

template <bool FOX>
__device__ __forceinline__ void unit(const Ctx& F, int b, int h, int qb) {
    constexpr int ND = FOX ? 4 : 6;
    const int lane = F.lane, wid = F.wave, r32 = lane & 31, hi = lane >> 5;
    const size_t rowbase = (size_t)b * SEQ; const int q0 = qb * 256;
    const bf16 *Qp, *Kp, *Vp; int qpitch, kpitch;
    if (FOX) { Qp = (const bf16*)(F.ws + R_FQ) + rowbase * 384 + h * 64; Kp = (const bf16*)(F.ws + R_FK) + rowbase * 384 + h * 64; Vp = (const bf16*)(F.ws + R_FV) + rowbase * 384 + h * 64; qpitch = 384; kpitch = 384; }
    else { Qp = (const bf16*)(F.ws + R_QM) + rowbase * 576 + h * 96; Kp = (const bf16*)(F.ws + R_KVM) + rowbase * 768 + h * 128; Vp = Kp + 64; qpitch = 576; kpitch = 768; }
    const bf16* KRp = (const bf16*)(F.ws + R_KR) + rowbase * 32;
    const float* Gp = (const float*)(F.ws + WS_G) + (size_t)(b * 6 + h) * SEQ;
    LAS unsigned char* lds = F.lds;
    LAS float* wsf = (LAS float*)(lds + WSF0) + wid * 64;
    LAS float* ost = (LAS float*)(lds + OST0 + wid * 8192);
    const int NT = (q0 + 256) / 64;
    bf16x8 qr[ND];
    { const bf16* Qw = Qp + (size_t)(q0 + wid * 32 + r32) * qpitch + hi * 8;
#pragma unroll
      for (int d0 = 0; d0 < ND; ++d0) qr[d0] = *(const bf16x8*)(Qw + d0 * 16); }
    u32x4 kreg0, kreg1 = {0u, 0u, 0u, 0u}, vreg; float greg = 0.f;
    const bf16* ksrc = Kp + (size_t)lane * kpitch + wid * 8;
    const bf16* krsrc = KRp + (size_t)lane * 32 + (wid & 3) * 8;
    const bf16* vsrc = Vp + (size_t)(16 * (wid & 3) + (lane >> 2)) * kpitch + (wid >> 2) * 32 + (lane & 3) * 8;
#define ATT_LOAD(t) do { kreg0 = *(const u32x4*)(ksrc + (size_t)(t) * 64 * kpitch); if (!FOX && wid < 4) kreg1 = *(const u32x4*)(krsrc + (size_t)(t) * 64 * 32); \
        vreg = *(const u32x4*)(vsrc + (size_t)(t) * 64 * kpitch); if (FOX && wid == 0) greg = Gp[(t) * 64 + lane]; } while (0)
#define ATT_STORE(buf) do { *(LAS u32x4*)(lds + KB0 + (buf) * KBSZ + wid * 1024 + lane * 16) = kreg0; if (!FOX && wid < 4) *(LAS u32x4*)(lds + KB0 + (buf) * KBSZ + (8 + wid) * 1024 + lane * 16) = kreg1; \
        *(LAS u32x4*)(lds + VB0 + (buf) * VBSZ + wid * 1024 + lane * 16) = vreg; if (FOX && wid == 0) *(LAS float*)(lds + GB0 + (buf) * 256 + lane * 4) = greg; } while (0)
    f32x16 o[2]; o[0] = f32x16{}; o[1] = f32x16{};
    float m_run = -INFINITY, l_run = 0.f;
    const int qmin = q0 + wid * 32, qabs = qmin + r32;
    ATT_LOAD(0); ATT_STORE(0);
    __syncthreads();
    for (int t = 0; t < NT; ++t) {
        const int buf = t & 1;
        if (t + 1 < NT) ATT_LOAD(t + 1);
        if (64 * t <= qmin + 31) {
            const LAS unsigned char* kb = lds + KB0 + buf * KBSZ + hi * 1024 + r32 * 16;
            f32x16 p0 = f32x16{}, p1 = f32x16{};
#pragma unroll
            for (int d0 = 0; d0 < ND; ++d0) {
                const bf16x8 k0f = *(const LAS bf16x8*)(kb + d0 * 2048), k1f = *(const LAS bf16x8*)(kb + d0 * 2048 + 512);
                p0 = __builtin_amdgcn_mfma_f32_32x32x16_bf16(k0f, qr[d0], p0, 0, 0, 0);
                p1 = __builtin_amdgcn_mfma_f32_32x32x16_bf16(k1f, qr[d0], p1, 0, 0, 0);
            }
            if (FOX) {
                const LAS float* gb = (const LAS float*)(lds + GB0 + buf * 256);
#pragma unroll
                for (int g = 0; g < 4; ++g) { const f32x4 a = *(const LAS f32x4*)(gb + 8 * g + 4 * hi), c = *(const LAS f32x4*)(gb + 32 + 8 * g + 4 * hi);
#pragma unroll
                    for (int j = 0; j < 4; ++j) { p0[4 * g + j] += a[j]; p1[4 * g + j] += c[j]; } }
            }
            if (64 * t + 63 > qmin) {
#pragma unroll
                for (int r = 0; r < 16; ++r) { const int kv = 64 * t + crow(r, hi); if (kv > qabs) p0[r] = -INFINITY; if (kv + 32 > qabs) p1[r] = -INFINITY; }
            }
            float mx = p0[0];
#pragma unroll
            for (int r = 1; r < 16; ++r) mx = fmaxf(mx, p0[r]);
#pragma unroll
            for (int r = 0; r < 16; ++r) mx = fmaxf(mx, p1[r]);
            mx = fmaxf(mx, lane_xor(mx, lane, 32));
            const float m_new = fmaxf(m_run, mx);
            const float alpha = __builtin_amdgcn_exp2f(m_run - m_new);
            m_run = m_new;
            float ls = 0.f;
#pragma unroll
            for (int r = 0; r < 16; ++r) { p0[r] = __builtin_amdgcn_exp2f(p0[r] - m_new); p1[r] = __builtin_amdgcn_exp2f(p1[r] - m_new); ls += p0[r] + p1[r]; }
            l_run = l_run * alpha + ls;
            if (hi == 0) wsf[r32] = alpha;
            LDS_WAIT();
#pragma unroll
            for (int g = 0; g < 4; ++g) { const f32x4 a = *(const LAS f32x4*)(wsf + 8 * g + 4 * hi);
#pragma unroll
                for (int j = 0; j < 4; ++j) { o[0][4 * g + j] *= a[j]; o[1][4 * g + j] *= a[j]; } }
            u32x4 pw[4];
#pragma unroll
            for (int s = 0; s < 2; ++s) {
                pw[s] = (u32x4){pk2(p0[8 * s], p0[8 * s + 1]), pk2(p0[8 * s + 2], p0[8 * s + 3]), pk2(p0[8 * s + 4], p0[8 * s + 5]), pk2(p0[8 * s + 6], p0[8 * s + 7])};
                pw[2 + s] = (u32x4){pk2(p1[8 * s], p1[8 * s + 1]), pk2(p1[8 * s + 2], p1[8 * s + 3]), pk2(p1[8 * s + 4], p1[8 * s + 5]), pk2(p1[8 * s + 6], p1[8 * s + 7])};
            }
            const LAS unsigned char* vb = lds + VB0 + buf * VBSZ + ((lane >> 4) & 1) * 32 + (lane & 3) * 8 + (4 * hi + ((lane & 15) >> 2)) * 64;
#pragma unroll
            for (int d0 = 0; d0 < 2; ++d0)
#pragma unroll
                for (int ks = 0; ks < 4; ++ks) {
                    const s16x4 lo = vtr(vb + d0 * 4096 + ks * 1024), hh = vtr(vb + d0 * 4096 + ks * 1024 + 512);
                    const bf16x8 vf = (bf16x8){lo[0], lo[1], lo[2], lo[3], hh[0], hh[1], hh[2], hh[3]};
                    o[d0] = __builtin_amdgcn_mfma_f32_32x32x16_bf16(__builtin_bit_cast(bf16x8, pw[ks]), vf, o[d0], 0, 0, 0);
                }
        }
        if (t + 1 < NT) ATT_STORE(buf ^ 1);
        __syncthreads();
    }
#undef ATT_LOAD
#undef ATT_STORE
    float lt = l_run + lane_xor(l_run, lane, 32);
    if (hi == 0) wsf[r32] = 1.0f / lt;
    LDS_WAIT();
#pragma unroll
    for (int g = 0; g < 4; ++g) { const f32x4 a = *(const LAS f32x4*)(wsf + 8 * g + 4 * hi);
#pragma unroll
        for (int j = 0; j < 4; ++j) { ost[crow(4 * g + j, hi) * 64 + r32] = o[0][4 * g + j] * a[j]; ost[crow(4 * g + j, hi) * 64 + 32 + r32] = o[1][4 * g + j] * a[j]; } }
    LDS_WAIT();
    bf16* OM = (bf16*)(F.ws + R_OM) + (rowbase + q0 + wid * 32) * 1024 + (FOX ? h * 64 : 640 + h * 64);
#pragma unroll
    for (int i = 0; i < 4; ++i) {
        const int row = i * 8 + (lane >> 3), ch = lane & 7;
        const f32x4 a = *(const LAS f32x4*)(ost + row * 64 + ch * 8), c = *(const LAS f32x4*)(ost + row * 64 + ch * 8 + 4);
        float s = (a[0] * a[0] + a[1] * a[1]) + (a[2] * a[2] + a[3] * a[3]) + (c[0] * c[0] + c[1] * c[1]) + (c[2] * c[2] + c[3] * c[3]);
        s += lane_xor(s, lane, 1); s += lane_xor(s, lane, 2); s += lane_xor(s, lane, 4);
        const float rstd = 1.0f / sqrtf(s * (1.f / 64.f) + RMS_EPS);
        u32x4 w; w.x = pk2(a[0] * rstd, a[1] * rstd); w.y = pk2(a[2] * rstd, a[3] * rstd); w.z = pk2(c[0] * rstd, c[1] * rstd); w.w = pk2(c[2] * rstd, c[3] * rstd);
        *(u32x4*)(OM + (size_t)row * 1024 + ch * 8) = w;
    }
    LDS_WAIT();
}

__device__ __forceinline__ void phase(const Ctx& F, int l) {
    unsigned* ctr = F.ctl + CW_AQ + 64 * l;
    for (;;) {
        if (F.tid == 0) F.MISC[4] = __hip_atomic_fetch_add(ctr, 1u, RLX_AGENT);
        __syncthreads();
        const int u = (int)F.MISC[4];
        __syncthreads();
        if (u >= 768) break;
        const int qb = 15 - u / 48, rem = u % 48, type = rem / 24, bh = rem % 24, b = bh / 6, h = bh % 6;
        if (type == 0) unit<false>(F, b, h, qb); else unit<true>(F, b, h, qb);
    }
}
}

__device__ __forceinline__ void moe_tables(const Ctx& F, int nN) {
    if (F.tid == 0) { int s = 0, up = 0;
        for (int e = 0; e < 8; ++e) { const int c = (int)__hip_atomic_load(F.ctl + CW_CNT + 64 * e, RLX_AGENT), nM = (c + 255) >> 8; F.TAB[e] = c; F.TAB[8 + e] = s; F.TAB[16 + e] = up; F.TAB[25 + e] = nM; s += c; up += nM * nN; }
        F.TAB[24] = up; }
    __syncthreads();
}

__global__ void __launch_bounds__(NWAVES * 64, 2) mk_fwd(Args args) {
    extern __shared__ __attribute__((aligned(16))) unsigned char lds_raw[];
    Ctx F;
    F.lds = (LAS unsigned char*)lds_raw; F.MISC = (volatile LAS unsigned*)(F.lds + MISC_OFF); F.TAB = (volatile LAS int*)(F.lds + TAB_OFF);
    F.tid = threadIdx.x; F.lane = F.tid & 63; F.wave = __builtin_amdgcn_readfirstlane(F.tid >> 6);
    { const int bx = blockIdx.x; F.vcu = (bx % 8) * (NBLK / 8) + bx / 8; }
    F.ws = args.ws; F.ctl = (unsigned*)(args.ws + WS_CTL); F.in = args.in; F.out = args.out;
    for (int u = F.tid; u < (LDS_BYTES - RING_BYTES) / 4; u += NWAVES * 64) ((LAS unsigned*)(F.lds + RING_BYTES))[u] = 0u;
    __syncthreads();
    const int lo = args.ph_lo, hi = args.ph_hi;
    XcdBarrier bar; bar.bar = F.ctl + CW_BAR; bar.x = 0; bar.st = nullptr;
    if (hi - lo > 1) bar = xcd_barrier_post(F.ctl + CW_BAR, F.MISC + 8);
    const int G = NBLK, cb = (int)blockIdx.x;

    for (int ph = lo; ph < hi; ++ph) {
        { int t_ = threadIdx.x; asm volatile("" : "+v"(t_)); F.tid = t_; F.lane = t_ & 63; F.wave = __builtin_amdgcn_readfirstlane(t_ >> 6); }
        if (ph == 0) { if (PHM(8)) p0a(F); }
        else if (ph == 1) { if (PHM(9)) row_phase<0>(F, 0, false); }
        else {
            const int l = (ph - 2) >> 3, s = (ph - 2) & 7; const bool moe = (l == 1);
            if (s == 0 && PHM(0)) {
                g8::SchedPlain S{(const char*)(F.ws + WS_H), (const char*)(F.ws + R_WIN) + (size_t)l * INP * 1024 * 2, T / 256, INP / 256, 1024, G, cb};
                g8::EpiIn E{(bf16*)(F.ws + R_FQ), (bf16*)(F.ws + R_FK), (bf16*)(F.ws + R_FV), (bf16*)(F.ws + R_KR), (bf16*)(F.ws + R_CONV3), (bf16*)(F.ws + R_CQ), (bf16*)(F.ws + R_CKV),
                            (float*)(F.ws + WS_LOGF), (float*)(F.ws + WS_SSQ), F.in[I_BF] + l * 6, (const f32x2*)(F.ws + WS_CS)};
                g8::gemm_phase<g8::EpiIn, g8::SchedPlain, false>(F.lds, F.tid, 1024, S, E);
            } else if (s == 1 && PHM(1)) {
#ifndef NO_SCANCONV
                scan_conv(F, l);
#endif
                { int t_ = threadIdx.x; asm volatile("" : "+v"(t_)); F.tid = t_; F.lane = t_ & 63; }
                { g8::SchedPlain S{(const char*)(F.ws + R_CQ), (const char*)(F.ws + R_WUQ) + (size_t)l * 768 * 256 * 2, T / 256, 3, 256, G, cb};
                  g8::EpiUp<0> E{(bf16*)(F.ws + R_QM), (bf16*)(F.ws + R_KVM), (const float*)(F.ws + WS_SSQ), (const f32x2*)(F.ws + WS_CS)};
                  g8::gemm_phase<g8::EpiUp<0>, g8::SchedPlain, false>(F.lds, F.tid, 256, S, E); }
                { int t_ = threadIdx.x; asm volatile("" : "+v"(t_)); F.tid = t_; F.lane = t_ & 63; }
                { g8::SchedPlain S{(const char*)(F.ws + R_CKV), (const char*)(F.ws + R_WUKV) + (size_t)l * 768 * 256 * 2, T / 256, 3, 256, G, (cb + 128) & 255};
                  g8::EpiUp<1> E{(bf16*)(F.ws + R_QM), (bf16*)(F.ws + R_KVM), (const float*)(F.ws + WS_SSQ), (const f32x2*)(F.ws + WS_CS)};
                  g8::gemm_phase<g8::EpiUp<1>, g8::SchedPlain, false>(F.lds, F.tid, 256, S, E); }
            } else if (s == 2 && PHM(2)) {
                att::phase(F, l);
            } else if (s == 3 && PHM(3)) {
                g8::SchedPlain S{(const char*)(F.ws + R_OM), (const char*)(F.ws + R_WO) + (size_t)l * 1024 * 1024 * 2, T / 256, 4, 1024, G, cb};
                g8::EpiF32 E{(float*)(F.ws + R_Y), 1024};
                g8::gemm_phase<g8::EpiF32, g8::SchedPlain, false>(F.lds, F.tid, 1024, S, E);
            } else if (s == 4 && PHM(4)) {
                row_phase<1>(F, l, moe);
            } else if (s == 5) {
                if (!moe) { if (PHM(5)) {
                    g8::SchedPlain S{(const char*)(F.ws + WS_H), (const char*)(F.ws + R_WGU), T / 256, 2 * DFF / 256, 1024, G, cb};
                    g8::EpiSwiGLU E{(bf16*)(F.ws + R_ACT), DFF};
                    g8::gemm_phase<g8::EpiSwiGLU, g8::SchedPlain, false>(F.lds, F.tid, 1024, S, E); }
                } else if (PHM(10)) {
                    moe_tables(F, 2 * DEXP / 256);
                    g8::SchedMoE S{(const char*)(F.ws + WS_H), (const char*)(F.ws + WS_WEGU), (size_t)7168 * 1024 * 2, (const int*)(F.ws + WS_ROWL), F.TAB, 2 * DEXP / 256, 1024, G, cb, true};
                    g8::EpiSwiGLU E{(bf16*)(F.ws + R_ACTM), DEXP};
                    g8::gemm_phase<g8::EpiSwiGLU, g8::SchedMoE, true>(F.lds, F.tid, 1024, S, E);
                }
            } else if (s == 6) {
                if (!moe) { if (PHM(6)) {
                    g8::SchedPlain S{(const char*)(F.ws + R_ACT), (const char*)(F.ws + R_WD), T / 256, 4, DFF, G, cb};
                    g8::EpiF32 E{(float*)(F.ws + R_Y), 1024};
                    g8::gemm_phase<g8::EpiF32, g8::SchedPlain, false>(F.lds, F.tid, DFF, S, E); }
                } else if (PHM(11)) {
                    moe_tables(F, 4);
                    g8::SchedMoE S{(const char*)(F.ws + R_ACTM), (const char*)(F.ws + WS_WED), (size_t)1024 * DEXP * 2, (const int*)(F.ws + WS_ROWL), F.TAB, 4, DEXP, G, cb, false};
                    g8::EpiBf16Rows E{(bf16*)(F.ws + WS_WEGU), 1024};
                    g8::gemm_phase<g8::EpiBf16Rows, g8::SchedMoE, false>(F.lds, F.tid, DEXP, S, E);
                }
            } else if (s == 7 && PHM(7)) {
                row_phase<2>(F, l, moe);
            }
        }
        if (ph + 1 < hi) xcd_barrier(bar);
    }
}

constexpr int N_PHASES = 18;
extern "C" void kernel_launch(void* const* d_in, const int* in_sizes, int n_in, void* d_out, int out_size, void* d_ws, size_t ws_size, hipStream_t stream) {
    static int ready = 0;
    if (ready == 0) {
        if (n_in != 24 || out_size != T * DM || ws_size < WS_END) { fprintf(stderr, "kernel_launch: unexpected problem (n_in %d, out %d, ws %zu < %zu)\n", n_in, out_size, ws_size, (size_t)WS_END); ready = -1; return; }
        if (hipFuncSetAttribute((const void*)mk_fwd, hipFuncAttributeMaxDynamicSharedMemorySize, LDS_BYTES) != hipSuccess) { fprintf(stderr, "kernel_launch: hipFuncSetAttribute failed\n"); ready = -1; return; }
        int per_cu = 0;
        if (hipOccupancyMaxActiveBlocksPerMultiprocessor(&per_cu, (const void*)mk_fwd, NWAVES * 64, LDS_BYTES) != hipSuccess || per_cu < 1) fprintf(stderr, "kernel_launch: occupancy query reports %d\n", per_cu);
        (void)hipGetLastError();
        ready = 1;
    }
    if (ready < 0) return;
    (void)hipMemsetAsync((char*)d_ws + WS_CTL, 0, CTL_ZERO_BYTES, stream);
    Args a{};
    for (int i = 0; i < 24; ++i) a.in[i] = (const float*)d_in[i];
    a.out = (float*)d_out; a.ws = (unsigned char*)d_ws;
#if MK_N_LAUNCHES == 1
    a.ph_lo = 0; a.ph_hi = N_PHASES;
    hipLaunchKernelGGL(mk_fwd, dim3(NBLK), dim3(NWAVES * 64), LDS_BYTES, stream, a);
#else
    for (int p = 0; p < N_PHASES; ++p) { a.ph_lo = p; a.ph_hi = p + 1; hipLaunchKernelGGL(mk_fwd, dim3(NBLK), dim3(NWAVES * 64), LDS_BYTES, stream, a); }
#endif
}
```

```cpp
#include <hip/hip_runtime.h>
#include <cstdio>
#include <cstdint>

#ifndef MK_N_LAUNCHES
#define MK_N_LAUNCHES 1
#endif

#ifndef PH_MASK
#define PH_MASK 0xFFF
#endif
#define PHM(k) ((PH_MASK >> (k)) & 1)
#define LAS __attribute__((address_space(3)))
typedef unsigned short bf16;
typedef short bf16x8 __attribute__((ext_vector_type(8)));
typedef short s16x4 __attribute__((ext_vector_type(4)));
typedef float f32x2 __attribute__((ext_vector_type(2)));
typedef float f32x4 __attribute__((ext_vector_type(4)));
typedef float f32x16 __attribute__((ext_vector_type(16)));
typedef unsigned u32x2 __attribute__((ext_vector_type(2)));
typedef unsigned u32x4 __attribute__((ext_vector_type(4)));
typedef __bf16 bf16x2_t __attribute__((ext_vector_type(2)));

constexpr int DM = 1024, NBATCH = 4, SEQ = 4096, T = NBATCH * SEQ;
constexpr int HF = 6, HM = 6;
constexpr int INW = 2470, INP = 2560;
constexpr int DFF = 2816, NE = 8, DEXP = 3584;
constexpr int NBLK = 256, NWAVES = 8;
constexpr float LOG2E = 1.4426950408889634f;
constexpr float C2F = 0.125f * LOG2E;
constexpr float C2M = 0.10206207261596575f * LOG2E;
constexpr float ALPHA = 1.4142135623730951f;
constexpr float LN_EPS = 1e-5f, RMS_EPS = 1e-6f;

constexpr size_t MiB = 1u << 20, KiB = 1024;
constexpr size_t WS_CTL = 0, CTL_ZERO_BYTES = 1 * MiB;
constexpr size_t WS_MOD = 1 * MiB;
constexpr size_t WS_CS = WS_MOD + 256 * KiB;
constexpr size_t WS_G = WS_CS + 512 * KiB;
constexpr size_t WS_LOGF = WS_G + 512 * KiB;
constexpr size_t WS_SSQ = WS_LOGF + 512 * KiB;
constexpr size_t WS_ROWL = WS_SSQ + 512 * KiB;
constexpr size_t WS_TOKP = WS_ROWL + 512 * KiB;
constexpr size_t WS_TOKW = WS_TOKP + 128 * KiB;
constexpr size_t WS_WEGU = 8 * MiB;
constexpr size_t WS_WED = 120 * MiB;
constexpr size_t WS_RA = 176 * MiB;
constexpr size_t WS_H = 240 * MiB;
constexpr size_t WS_R = 272 * MiB;
constexpr size_t WS_END = 498 * MiB;
constexpr size_t R_WIN = WS_R, R_WUQ = WS_R + 10 * MiB, R_WUKV = R_WUQ + 768 * KiB, R_WO = R_WUKV + 768 * KiB, R_WGU = R_WO + 4 * MiB, R_WD = R_WGU + 11 * MiB;
constexpr size_t R_Y = WS_R + 32 * MiB;
constexpr size_t R_CONV3 = WS_R + 32 * MiB, R_CQ = WS_R + 56 * MiB, R_CKV = WS_R + 64 * MiB, R_QM = WS_R + 72 * MiB, R_KVM = WS_R + 90 * MiB, R_OM = WS_R + 114 * MiB;
constexpr size_t R_FQ = WS_R + 146 * MiB, R_FK = WS_R + 158 * MiB, R_FV = WS_R + 170 * MiB, R_KR = WS_R + 182 * MiB;
constexpr size_t R_ACT = WS_R + 96 * MiB;
constexpr size_t R_ACTM = WS_R;
static_assert(R_WD + (size_t)DM * DFF * 2 <= R_Y, "weights fit");
static_assert(R_ACT + (size_t)T * DFF * 2 <= WS_END && R_ACTM + (size_t)(32768 + 256) * DEXP * 2 <= WS_END, "act fits");
constexpr int CW_BAR = 4096, CW_CNT = 8192, CW_AQ = 9216;

constexpr int RING_BYTES = 131072, SCR_BYTES = 135168  , MISC_OFF = SCR_BYTES + 320, TAB_OFF = SCR_BYTES + 1024, LDS_BYTES = 147456;
static_assert(8 * 16640 <= SCR_BYTES, "prologue scratch");

__device__ __forceinline__ unsigned pk2(float lo, float hi) { f32x2 v = {lo, hi}; bf16x2_t b = __builtin_convertvector(v, bf16x2_t); return __builtin_bit_cast(unsigned, b); }
__device__ __forceinline__ float bflo(unsigned u) { return __uint_as_float(u << 16); }
__device__ __forceinline__ float bfhi(unsigned u) { return __uint_as_float(u & 0xffff0000u); }
__device__ __forceinline__ float lane_get(float v, int src) { return __int_as_float(__builtin_amdgcn_ds_bpermute(src << 2, __float_as_int(v))); }
__device__ __forceinline__ float lane_xor(float v, int lane, int o) { return lane_get(v, lane ^ o); }
__device__ __forceinline__ float wave_sum(float v, int lane) {
#pragma unroll
    for (int o = 1; o < 64; o <<= 1) v += lane_xor(v, lane, o);
    return v;
}
#define LDS_WAIT() asm volatile("s_waitcnt lgkmcnt(0)" ::: "memory")
#define VM_WAIT() asm volatile("s_waitcnt vmcnt(0)" ::: "memory")
#define RLX_AGENT __ATOMIC_RELAXED, __HIP_MEMORY_SCOPE_AGENT

namespace g8 {
constexpr int BM = 256, BK = 64, HALF = 128, HTB = HALF * BK * 2, STAGE_BYTES = 8 * HTB, NXCD = 8, WGM = 8;
__host__ __device__ __forceinline__ int lds_byte(int r, int c) { const int st = (r >> 4) * 2 + (c >> 5), rr = r & 15, cc = c & 31, ob = rr * 64 + cc * 2; return st * 1024 + (ob ^ (((ob >> 9) & 1) << 5)); }
__host__ __device__ __forceinline__ void stage_rc(int b, int& R, int& C) { const int st = b / 1024, sb = b % 1024, swz = sb ^ (((sb >> 9) & 1) << 5); R = (st >> 1) * 16 + swz / 64; C = (st & 1) * 32 + (swz % 64) / 2; }
__host__ __device__ __forceinline__ int perm32(int rho) { const int n = rho >> 4, i = rho & 15; return 8 * (i >> 2) + 4 * n + (i & 3); }

struct Unit { int pm, pn, grp, mvalid, rowbase; const char* a; const char* b; const int* rl; };

__device__ __forceinline__ int xcd_remap(int wgid, int nwg) { const int q = nwg / NXCD, r = nwg % NXCD, xcd = wgid % NXCD, off = wgid / NXCD; return (xcd < r ? xcd * (q + 1) : r * (q + 1) + (xcd - r) * q) + off; }
__device__ __forceinline__ void grouped_pmpn(int local, int nM, int nN, int& pm, int& pn) {
    const int nig = WGM * nN, gid = local / nig, fm = gid * WGM, gsz = (nM - fm) < WGM ? (nM - fm) : WGM;
    pm = fm + ((local % nig) % gsz); pn = (local % nig) / gsz;
}
struct SchedPlain {
    const char* A; const char* Bt; int nM, nN, K, G, c;
    __device__ __forceinline__ bool next(int i, Unit& u) const {
        const int nwg = nM * nN; const long L = (long)i * G + c; if (L >= nwg) return false;
        const int wgid = xcd_remap((int)L, nwg); int pm, pn; grouped_pmpn(wgid, nM, nN, pm, pn);
        u.pm = pm; u.pn = pn; u.grp = 0; u.mvalid = 256; u.rowbase = pm * 256; u.a = A + (size_t)pm * 256 * K * 2; u.b = Bt + (size_t)pn * 256 * K * 2; u.rl = nullptr; return true;
    }
};
struct SchedPair {
    const char* A0; const char* B0; const char* A1; const char* B1; int nM, nN, K, G, c;
    __device__ __forceinline__ bool next(int i, Unit& u) const {
        const int per = nM * nN, nwg = 2 * per; const long L = (long)i * G + c; if (L >= nwg) return false;
        const int wgid = xcd_remap((int)L, nwg); const int grp = wgid / per; int pm, pn; grouped_pmpn(wgid % per, nM, nN, pm, pn);
        u.pm = pm; u.pn = pn; u.grp = grp; u.mvalid = 256; u.rowbase = pm * 256;
        u.a = (grp ? A1 : A0) + (size_t)pm * 256 * K * 2; u.b = (grp ? B1 : B0) + (size_t)pn * 256 * K * 2; u.rl = nullptr; return true;
    }
};
struct SchedMoE {
    const char* A; const char* Bt; size_t bexp; const int* rowl; volatile LAS int* tab; int nN, K, G, c; bool gather;
    __device__ __forceinline__ int tb(int i) const { return __builtin_amdgcn_readfirstlane(tab[i]); }
    __device__ __forceinline__ bool next(int i, Unit& u) const {
        const int nwg = tb(24); const long L = (long)i * G + c; if (L >= nwg) return false;
        const int wgid = xcd_remap((int)L, nwg);
        int e = 0;
#pragma unroll
        for (int j = 1; j < 8; ++j) if (wgid >= tb(16 + j)) e = j;
        const int local = wgid - tb(16 + e), nM = tb(25 + e), cnt = tb(e), start = tb(8 + e);
        int pm, pn; grouped_pmpn(local, nM, nN, pm, pn);
        u.pm = pm; u.pn = pn; u.grp = e; u.mvalid = (cnt - pm * 256) < 256 ? (cnt - pm * 256) : 256; u.rowbase = start + pm * 256;
        u.a = gather ? A : A + (size_t)(start + pm * 256) * K * 2; u.b = Bt + (size_t)e * bexp + (size_t)pn * 256 * K * 2; u.rl = rowl + e * 16384 + pm * 256; return true;
    }
};

template <class Epi, class Sched, bool GATHER>
__device__ __forceinline__ void gemm_phase(LAS unsigned char* lds, const int tid, const int K, const Sched& S, const Epi& E) {
    const int wid = __builtin_amdgcn_readfirstlane(tid >> 6), lane = tid & 63, wr = wid >> 2, wc = wid & 3, fr = lane & 15, fq = lane >> 4;
    const int nt = K / BK;
    int RA[2], CA[2]; unsigned voffB[2];
#pragma unroll
    for (int i = 0; i < 2; ++i) { int R, C; stage_rc(tid * 16 + i * 8192, R, C); const int Rb = Epi::PERM ? ((R & ~31) + perm32(R & 31)) : R; RA[i] = R; CA[i] = C; voffB[i] = (unsigned)(Rb * K + C) * 2u; }
    const size_t kstep = (size_t)(BK * 2);
    const size_t hstep = (size_t)HALF * K * 2;
    const unsigned ldsw = (unsigned)wid * 1024u;
    const int aoff = lds_byte(wr * 64 + fr, fq * 8), boff = lds_byte(wc * 32 + fr, fq * 8);
#define G8_SA(b, h) (((b) * 2 + (h)) * HTB)
#define G8_SB(b, h) ((4 + (b) * 2 + (h)) * HTB)
#define G8_STAGE_B(bufoff, gbase) do { _Pragma("unroll") for (int _i = 0; _i < 2; ++_i) \
        __builtin_amdgcn_global_load_lds((const unsigned*)((const char*)(gbase) + voffB[_i]), (LAS unsigned*)(lds + (bufoff) + ldsw + _i * 8192), 16, 0, 0); } while (0)
#define G8_STAGE_A(bufoff, gbase, AO, h) do { _Pragma("unroll") for (int _i = 0; _i < 2; ++_i) \
        __builtin_amdgcn_global_load_lds((const unsigned*)((const char*)(gbase) + AO[h][_i]), (LAS unsigned*)(lds + (bufoff) + ldsw + _i * 8192), 16, 0, 0); } while (0)
#define G8_LDA(dst, b, h) do { _Pragma("unroll") for (int m = 0; m < 4; ++m) _Pragma("unroll") for (int k = 0; k < 2; ++k) dst[m][k] = *(const LAS bf16x8*)(lds + G8_SA(b, h) + aoff + m * 2048 + k * 1024); } while (0)
#define G8_LDB(dst, b, h) do { _Pragma("unroll") for (int n = 0; n < 2; ++n) _Pragma("unroll") for (int k = 0; k < 2; ++k) dst[n][k] = *(const LAS bf16x8*)(lds + G8_SB(b, h) + boff + n * 2048 + k * 1024); } while (0)
#define G8_MMA(ai, bj, At, Bt) do { __builtin_amdgcn_s_setprio(1); _Pragma("unroll") for (int m = 0; m < 4; ++m) _Pragma("unroll") for (int n = 0; n < 2; ++n) _Pragma("unroll") for (int k = 0; k < 2; ++k) \
        acc[ai][bj][m][n] = __builtin_amdgcn_mfma_f32_16x16x32_bf16(Bt[n][k], At[m][k], acc[ai][bj][m][n], 0, 0, 0); __builtin_amdgcn_s_setprio(0); } while (0)
#define G8_WAIT_V(n) asm volatile("s_waitcnt vmcnt(" #n ")" ::: "memory")
#define G8_WAIT_L(n) asm volatile("s_waitcnt lgkmcnt(" #n ")" ::: "memory")
#define G8_BAR __builtin_amdgcn_s_barrier()
#define G8_SCHED __builtin_amdgcn_sched_barrier(0)
#define G8_AOFF(AO, U) do { _Pragma("unroll") for (int _h = 0; _h < 2; ++_h) _Pragma("unroll") for (int _i = 0; _i < 2; ++_i) { \
        if constexpr (GATHER) { const int _r = _h * HALF + RA[_i]; const int _tok = (_r < (U).mvalid) ? (U).rl[_r] : 0; AO[_h][_i] = (unsigned)_tok * (unsigned)(K * 2) + (unsigned)(CA[_i] * 2); } \
        else AO[_h][_i] = (unsigned)((_h * HALF + RA[_i]) * K + CA[_i]) * 2u; } } while (0)
    Unit cur, nxt; int ui = 0;
    if (!S.next(0, cur)) return;
    f32x4 acc[2][2][4][2];
#pragma unroll
    for (int a = 0; a < 2; ++a)
#pragma unroll
        for (int b = 0; b < 2; ++b)
#pragma unroll
            for (int m = 0; m < 4; ++m)
#pragma unroll
                for (int n = 0; n < 2; ++n) acc[a][b][m][n] = (f32x4){0.f, 0.f, 0.f, 0.f};
    bf16x8 At[4][2], B0[2][2], B1[2][2];
    unsigned aoc[2][2], aon[2][2];
    G8_AOFF(aoc, cur);
    if constexpr (GATHER) { VM_WAIT(); }
    const char* cA = cur.a; const char* cB = cur.b;
    G8_STAGE_B(G8_SB(0, 0), cB); G8_STAGE_B(G8_SB(0, 1), cB + hstep); G8_STAGE_A(G8_SA(0, 0), cA, aoc, 0); G8_STAGE_A(G8_SA(0, 1), cA, aoc, 1);
    if (wr == 1) G8_BAR;
    G8_WAIT_V(2); G8_BAR;
    G8_STAGE_B(G8_SB(1, 0), cB + kstep); G8_STAGE_A(G8_SA(1, 0), cA + kstep, aoc, 0); G8_STAGE_B(G8_SB(1, 1), cB + hstep + kstep);
    G8_WAIT_V(6); G8_BAR;
    for (;;) {
        const bool has_next = S.next(ui + 1, nxt);
        const char* nA = has_next ? nxt.a : cA; const char* nB = has_next ? nxt.b : cB;
        if constexpr (GATHER) {
            if (has_next) { G8_AOFF(aon, nxt); }
            else {
#pragma unroll
                for (int h = 0; h < 2; ++h)
#pragma unroll
                    for (int i = 0; i < 2; ++i) aon[h][i] = aoc[h][i];
            }
        }
#pragma unroll 1
        for (int t = 0; t < nt; t += 2) {
            const bool last = (t == nt - 2);
            const char* a1 = cA + (size_t)(t + 1) * kstep;
            const char* a2 = last ? nA : cA + (size_t)(t + 2) * kstep; const char* b2 = last ? nB : cB + (size_t)(t + 2) * kstep;
            const char* a3 = a2 + kstep; const char* b3 = b2 + kstep;
            unsigned ao2[2][2];
#pragma unroll
            for (int h = 0; h < 2; ++h)
#pragma unroll
                for (int i = 0; i < 2; ++i) { if constexpr (GATHER) ao2[h][i] = last ? aon[h][i] : aoc[h][i]; else ao2[h][i] = aoc[h][i]; }
            G8_LDB(B0, 0, 0); G8_LDB(B1, 0, 1); G8_SCHED; G8_LDA(At, 0, 0); G8_STAGE_A(G8_SA(1, 1), a1, aoc, 1);
            G8_WAIT_V(8); G8_WAIT_L(0); G8_BAR; G8_MMA(0, 0, At, B0); G8_MMA(0, 1, At, B1); G8_BAR; G8_SCHED;
            G8_LDA(At, 0, 1); G8_STAGE_B(G8_SB(0, 0), b2); G8_STAGE_B(G8_SB(0, 1), b2 + hstep); G8_STAGE_A(G8_SA(0, 0), a2, ao2, 0);
            G8_WAIT_V(8); G8_WAIT_L(0); G8_BAR; G8_MMA(1, 0, At, B0); G8_MMA(1, 1, At, B1); G8_BAR; G8_SCHED;
            G8_LDB(B0, 1, 0); G8_LDB(B1, 1, 1); G8_SCHED; G8_LDA(At, 1, 0); G8_STAGE_A(G8_SA(0, 1), a2, ao2, 1);
            G8_WAIT_V(8); G8_WAIT_L(0); G8_BAR; G8_MMA(0, 0, At, B0); G8_MMA(0, 1, At, B1); G8_BAR; G8_SCHED;
            G8_LDA(At, 1, 1); G8_STAGE_B(G8_SB(1, 0), b3); G8_STAGE_B(G8_SB(1, 1), b3 + hstep); G8_STAGE_A(G8_SA(1, 0), a3, ao2, 0);
            G8_WAIT_V(8); G8_WAIT_L(0); G8_BAR; G8_MMA(1, 0, At, B0); G8_MMA(1, 1, At, B1); G8_BAR; G8_SCHED;
        }
        if (wr == 0) G8_BAR;
        E(acc, cur, wr, wc, fr, fq);
        if (!has_next) break;
#pragma unroll
        for (int a = 0; a < 2; ++a)
#pragma unroll
            for (int b = 0; b < 2; ++b)
#pragma unroll
                for (int m = 0; m < 4; ++m)
#pragma unroll
                    for (int n = 0; n < 2; ++n) acc[a][b][m][n] = (f32x4){0.f, 0.f, 0.f, 0.f};
        cur = nxt; cA = nA; cB = nB; ++ui;
        if constexpr (GATHER) {
#pragma unroll
            for (int h = 0; h < 2; ++h)
#pragma unroll
                for (int i = 0; i < 2; ++i) aoc[h][i] = aon[h][i];
        }
        if (wr == 1) G8_BAR;
    }
    G8_WAIT_V(0);
    G8_BAR;
#undef G8_SA
#undef G8_SB
#undef G8_STAGE_A
#undef G8_STAGE_B
#undef G8_LDA
#undef G8_LDB
#undef G8_MMA
#undef G8_WAIT_V
#undef G8_WAIT_L
#undef G8_BAR
#undef G8_SCHED
#undef G8_AOFF
}

__device__ __forceinline__ float log_sigmoid(float x) { return fminf(x, 0.f) - log1pf(__expf(-fabsf(x))); }
__device__ __forceinline__ float silu_mul(float g, float u) { return g * u / (1.f + __expf(-g)); }

struct EpiIn {
    static constexpr bool PERM = true;
    bf16 *FQ, *FK, *FV, *KR, *CONV3, *CQ, *CKV; float* LOGF; float* SSQ; const float* bf; const f32x2* CS;
    __device__ __forceinline__ void operator()(const f32x4 (&acc)[2][2][4][2], const Unit& u, int wr, int wc, int fr, int fq) const {
        asm volatile("" : "+v"(fr), "+v"(fq));
        const int row0 = u.pm * 256 + wr * 64 + fr;
#pragma unroll
        for (int bj = 0; bj < 2; ++bj) {
            const int hb = 2 * u.pn + bj;
            if (hb == 9) {
                if (wc == 0) {
#pragma unroll
                    for (int ai = 0; ai < 2; ++ai)
#pragma unroll
                        for (int m = 0; m < 4; ++m) {
                            const int row = row0 + ai * 128 + m * 16, t = row & (SEQ - 1);
                            const f32x4 v0 = acc[ai][bj][m][0], v1 = acc[ai][bj][m][1];
                            const f32x4 c01 = *(const f32x4*)(CS + t * 16 + 4 * fq), c23 = *(const f32x4*)(CS + t * 16 + 4 * fq + 2);
                            u32x4 w;
                            w.x = pk2(v0[0] * c01[0] - v0[1] * c01[1], v0[1] * c01[0] + v0[0] * c01[1]);
                            w.y = pk2(v0[2] * c01[2] - v0[3] * c01[3], v0[3] * c01[2] + v0[2] * c01[3]);
                            w.z = pk2(v1[0] * c23[0] - v1[1] * c23[1], v1[1] * c23[0] + v1[0] * c23[1]);
                            w.w = pk2(v1[2] * c23[2] - v1[3] * c23[3], v1[3] * c23[2] + v1[2] * c23[3]);
                            *(u32x4*)(KR + (size_t)row * 32 + 8 * fq) = w;
                        }
                } else if (wc == 1) {
                    if (fq == 0) {
#pragma unroll
                        for (int ai = 0; ai < 2; ++ai)
#pragma unroll
                            for (int m = 0; m < 4; ++m) {
                                const int row = row0 + ai * 128 + m * 16;
                                const f32x4 v0 = acc[ai][bj][m][0], v1 = acc[ai][bj][m][1];
                                f32x4 o0, o1;
                                o0[0] = log_sigmoid(v0[0] + bf[0]); o0[1] = log_sigmoid(v0[1] + bf[1]); o0[2] = log_sigmoid(v0[2] + bf[2]); o0[3] = log_sigmoid(v0[3] + bf[3]);
                                o1[0] = log_sigmoid(v1[0] + bf[4]); o1[1] = log_sigmoid(v1[1] + bf[5]); o1[2] = 0.f; o1[3] = 0.f;
                                *(f32x4*)(LOGF + (size_t)row * 8) = o0; *(f32x4*)(LOGF + (size_t)row * 8 + 4) = o1;
                            }
                    }
                }
                continue;
            }
            bf16* base; int ld, colo; float sc = 1.f;
            if (hb < 3) { base = FQ; ld = 384; colo = 128 * hb; sc = C2F; }
            else if (hb < 6) { base = FK; ld = 384; colo = 128 * (hb - 3); }
            else if (hb < 9) { base = FV; ld = 384; colo = 128 * (hb - 6); }
            else if (hb < 16) { base = CONV3; ld = 768; colo = 128 * (hb - 10); }
            else if (hb < 18) { base = CQ; ld = 256; colo = 128 * (hb - 16); }
            else { base = CKV; ld = 256; colo = 128 * (hb - 18); }
            const int col = colo + wc * 32 + 8 * fq;
#pragma unroll
            for (int ai = 0; ai < 2; ++ai)
#pragma unroll
                for (int m = 0; m < 4; ++m) {
                    const int row = row0 + ai * 128 + m * 16;
                    const f32x4 v0 = acc[ai][bj][m][0] * sc, v1 = acc[ai][bj][m][1] * sc;
                    u32x4 w; w.x = pk2(v0[0], v0[1]); w.y = pk2(v0[2], v0[3]); w.z = pk2(v1[0], v1[1]); w.w = pk2(v1[2], v1[3]);
                    *(u32x4*)(base + (size_t)row * ld + col) = w;
                }
        }
        if (u.pn >= 8) {
            float* sq = SSQ + (size_t)(u.pn - 8) * T * 4;
#pragma unroll
            for (int ai = 0; ai < 2; ++ai)
#pragma unroll
                for (int m = 0; m < 4; ++m) {
                    float s = 0.f;
#pragma unroll
                    for (int bj = 0; bj < 2; ++bj)
#pragma unroll
                        for (int n = 0; n < 2; ++n) { const f32x4 x = acc[ai][bj][m][n]; s += (x[0] * x[0] + x[1] * x[1]) + (x[2] * x[2] + x[3] * x[3]); }
                    s += lane_xor(s, fq * 16 + fr, 16); s += lane_xor(s, fq * 16 + fr, 32);
                    if (fq == 0) sq[(size_t)(row0 + ai * 128 + m * 16) * 4 + wc] = s;
                }
        }
    }
};

template <int GRP> struct EpiUp {
    static constexpr bool PERM = true;
    bf16 *QM, *KVM; const float* SSQ; const f32x2* CS;
    __device__ __forceinline__ void operator()(const f32x4 (&acc)[2][2][4][2], const Unit& u, int wr, int wc, int fr, int fq) const {
        asm volatile("" : "+v"(fr), "+v"(fq));
        const int row0 = u.pm * 256 + wr * 64 + fr;
        const float* sq = SSQ + (size_t)GRP * T * 4;
#pragma unroll
        for (int ai = 0; ai < 2; ++ai)
#pragma unroll
            for (int m = 0; m < 4; ++m) {
                const int row = row0 + ai * 128 + m * 16, t = row & (SEQ - 1);
                const f32x4 p = *(const f32x4*)(sq + (size_t)row * 4);
                const float rstd = 1.0f / sqrtf(((p[0] + p[1]) + (p[2] + p[3])) * (1.f / 256.f) + RMS_EPS);
#pragma unroll
                for (int bj = 0; bj < 2; ++bj) {
                    const int col = u.pn * 256 + bj * 128 + wc * 32 + 8 * fq;
                    if (GRP == 0) {
                        if (col < 576) {
                            const float s = rstd * C2M;
                            f32x4 v0 = acc[ai][bj][m][0] * s, v1 = acc[ai][bj][m][1] * s;
                            const int j = col % 96;
                            if (j >= 64) {
                                const int pi = (j - 64) >> 1;
                                const f32x4 c01 = *(const f32x4*)(CS + t * 16 + pi), c23 = *(const f32x4*)(CS + t * 16 + pi + 2);
                                f32x4 r0, r1;
                                r0[0] = v0[0] * c01[0] - v0[1] * c01[1]; r0[1] = v0[1] * c01[0] + v0[0] * c01[1];
                                r0[2] = v0[2] * c01[2] - v0[3] * c01[3]; r0[3] = v0[3] * c01[2] + v0[2] * c01[3];
                                r1[0] = v1[0] * c23[0] - v1[1] * c23[1]; r1[1] = v1[1] * c23[0] + v1[0] * c23[1];
                                r1[2] = v1[2] * c23[2] - v1[3] * c23[3]; r1[3] = v1[3] * c23[2] + v1[2] * c23[3];
                                v0 = r0; v1 = r1;
                            }
                            u32x4 w; w.x = pk2(v0[0], v0[1]); w.y = pk2(v0[2], v0[3]); w.z = pk2(v1[0], v1[1]); w.w = pk2(v1[2], v1[3]);
                            *(u32x4*)(QM + (size_t)row * 576 + col) = w;
                        }
                    } else {
                        const f32x4 v0 = acc[ai][bj][m][0] * rstd, v1 = acc[ai][bj][m][1] * rstd;
                        u32x4 w; w.x = pk2(v0[0], v0[1]); w.y = pk2(v0[2], v0[3]); w.z = pk2(v1[0], v1[1]); w.w = pk2(v1[2], v1[3]);
                        *(u32x4*)(KVM + (size_t)row * 768 + col) = w;
                    }
                }
                asm volatile("" ::: "memory"); __builtin_amdgcn_sched_barrier(0);
            }
    }
};

struct EpiF32 {
    static constexpr bool PERM = false;
    float* Y; int ldc;
    __device__ __forceinline__ void operator()(const f32x4 (&acc)[2][2][4][2], const Unit& u, int wr, int wc, int fr, int fq) const {
        asm volatile("" : "+v"(fr), "+v"(fq));
        const int row0 = u.pm * 256 + wr * 64 + fr, col0 = u.pn * 256 + wc * 32 + 4 * fq;
#pragma unroll
        for (int ai = 0; ai < 2; ++ai)
#pragma unroll
            for (int m = 0; m < 4; ++m) { float* rp = Y + (size_t)(row0 + ai * 128 + m * 16) * ldc + col0;
#pragma unroll
                for (int bj = 0; bj < 2; ++bj)
#pragma unroll
                    for (int n = 0; n < 2; ++n) *(f32x4*)(rp + bj * 128 + n * 16) = acc[ai][bj][m][n]; }
    }
};

struct EpiSwiGLU {
    static constexpr bool PERM = true;
    bf16* ACT; int ld;
    __device__ __forceinline__ void operator()(const f32x4 (&acc)[2][2][4][2], const Unit& u, int wr, int wc, int fr, int fq) const {
        asm volatile("" : "+v"(fr), "+v"(fq));
        const int col = u.pn * 128 + wc * 32 + 8 * fq;
#pragma unroll
        for (int ai = 0; ai < 2; ++ai)
#pragma unroll
            for (int m = 0; m < 4; ++m) {
                const int rt = ai * 128 + wr * 64 + m * 16 + fr;
                if (rt < u.mvalid) {
                    const f32x4 g0 = acc[ai][0][m][0], g1 = acc[ai][0][m][1], u0 = acc[ai][1][m][0], u1 = acc[ai][1][m][1];
                    u32x4 w;
                    w.x = pk2(silu_mul(g0[0], u0[0]), silu_mul(g0[1], u0[1])); w.y = pk2(silu_mul(g0[2], u0[2]), silu_mul(g0[3], u0[3]));
                    w.z = pk2(silu_mul(g1[0], u1[0]), silu_mul(g1[1], u1[1])); w.w = pk2(silu_mul(g1[2], u1[2]), silu_mul(g1[3], u1[3]));
                    *(u32x4*)(ACT + (size_t)(u.rowbase + rt) * ld + col) = w;
                }
                asm volatile("" ::: "memory"); __builtin_amdgcn_sched_barrier(0);
            }
    }
};

struct EpiBf16Rows {
    static constexpr bool PERM = true;
    bf16* O; int ld;
    __device__ __forceinline__ void operator()(const f32x4 (&acc)[2][2][4][2], const Unit& u, int wr, int wc, int fr, int fq) const {
        asm volatile("" : "+v"(fr), "+v"(fq));
#pragma unroll
        for (int ai = 0; ai < 2; ++ai)
#pragma unroll
            for (int m = 0; m < 4; ++m) {
                const int rt = ai * 128 + wr * 64 + m * 16 + fr;
                if (rt < u.mvalid) {
#pragma unroll
                    for (int bj = 0; bj < 2; ++bj) {
                        const f32x4 v0 = acc[ai][bj][m][0], v1 = acc[ai][bj][m][1];
                        u32x4 w; w.x = pk2(v0[0], v0[1]); w.y = pk2(v0[2], v0[3]); w.z = pk2(v1[0], v1[1]); w.w = pk2(v1[2], v1[3]);
                        *(u32x4*)(O + (size_t)(u.rowbase + rt) * ld + u.pn * 256 + bj * 128 + wc * 32 + 8 * fq) = w;
                    }
                }
                asm volatile("" ::: "memory"); __builtin_amdgcn_sched_barrier(0);
            }
    }
};
}

#define XB_TMO      128
#define XB_XCNT(j)  (256  + 64 * (j))
#define XB_XSUB(j)  (1280 + 64 * (j))
#define XB_XGEN(j)  (2304 + 64 * (j))
#define XB_TOP      3328
#define XB_TOPGEN   3392
#define XCD_BAR_WORDS 3456
#define XB_SPIN_CAP (1u << 20)
__device__ __forceinline__ unsigned xb_ld(unsigned* p)              { return __hip_atomic_load(p, __ATOMIC_RELAXED, __HIP_MEMORY_SCOPE_AGENT); }
__device__ __forceinline__ unsigned xb_add(unsigned* p, unsigned v) { return __hip_atomic_fetch_add(p, v, __ATOMIC_RELAXED, __HIP_MEMORY_SCOPE_AGENT); }
__device__ __forceinline__ unsigned xb_xcc_id() { return (unsigned)__builtin_amdgcn_s_getreg((3 << 11) | 20) & 0xFu; }
#define XB_SPIN(cond, bar) do { unsigned _sp = 0; while (cond) { __builtin_amdgcn_s_sleep(1); \
    if ((++_sp & 255u) == 0u) { if (xb_ld(&(bar)[XB_TMO])) break; if (_sp > XB_SPIN_CAP) { atomicAdd(&(bar)[XB_TMO], 1u); break; } } } } while (0)
struct XcdBarrier { unsigned* bar; unsigned x; volatile LAS unsigned* st; };
__device__ __forceinline__ XcdBarrier xcd_barrier_post(unsigned* bar, volatile LAS unsigned* st) {
    XcdBarrier b; b.bar = bar; b.x = xb_xcc_id(); b.st = st;
    if (threadIdx.x == 0) (void)xb_add(&bar[XB_XCNT(b.x)], 1u);
    return b;
}
__device__ __forceinline__ void xcd_barrier_complete(unsigned* bar, unsigned x, unsigned& nloc, unsigned& nx) {
    const unsigned G = gridDim.x * gridDim.y * gridDim.z;
    unsigned sum, cnt, mine, sp = 0u;
    for (;;) {
        sum = 0u; cnt = 0u; mine = 0u;
#pragma unroll
        for (unsigned j = 0; j < 16; ++j) { const unsigned c = xb_ld(&bar[XB_XCNT(j)]); sum += c; cnt += (c > 0u) ? 1u : 0u; mine = (j == x) ? c : mine; }
        if (sum == G) break;
        __builtin_amdgcn_s_sleep(1);
        if ((++sp & 255u) == 0u) { if (xb_ld(&bar[XB_TMO])) break; if (sp > XB_SPIN_CAP) { atomicAdd(&bar[XB_TMO], 1u); break; } }
    }
    nloc = mine > 0u ? mine : 1u; nx = cnt > 0u ? cnt : 1u;
}
__device__ __forceinline__ void xcd_barrier(const XcdBarrier& b) {
    asm volatile("s_waitcnt vmcnt(0)" ::: "memory");
    __syncthreads();
    if (threadIdx.x == 0) {
        unsigned* bar = b.bar;
        __builtin_amdgcn_s_waitcnt(0);
        unsigned nloc = b.st[0], nx = b.st[1];
        if (nloc == 0u) { xcd_barrier_complete(bar, b.x, nloc, nx); b.st[0] = nloc; b.st[1] = nx; }
        const unsigned old = xb_add(&bar[XB_XSUB(b.x)], 1u);
        const unsigned gen = old / nloc;
        if (old + 1u == (gen + 1u) * nloc) {
            __builtin_amdgcn_fence(__ATOMIC_RELEASE, "agent");
            asm volatile("s_waitcnt vmcnt(0)" ::: "memory");
            const unsigned og = xb_add(&bar[XB_TOP], 1u);
            const unsigned tg = og / nx;
            if (og + 1u == (tg + 1u) * nx) xb_add(&bar[XB_TOPGEN], 1u);
            else XB_SPIN(xb_ld(&bar[XB_TOPGEN]) == tg, bar);
            __builtin_amdgcn_fence(__ATOMIC_ACQUIRE, "agent");
            xb_add(&bar[XB_XGEN(b.x)], 1u);
            asm volatile("s_waitcnt vmcnt(0)" ::: "memory");
        } else {
            XB_SPIN(xb_ld(&bar[XB_XGEN(b.x)]) == gen, bar);
            __builtin_amdgcn_fence(__ATOMIC_ACQUIRE, "agent");
            asm volatile("s_waitcnt vmcnt(0)" ::: "memory");
        }
    }
    __syncthreads();
}

struct Args { const float* in[24]; float* out; unsigned char* ws; int ph_lo, ph_hi; };
enum { I_X = 0, I_C, I_WMOD, I_BMOD, I_WIN, I_BF, I_WCONV, I_QG, I_KVG, I_WUQ, I_WUKV, I_HG, I_WO, I_LN1G, I_LN1B, I_LN2G, I_LN2B, I_FWG, I_FWU, I_FWD, I_RW, I_EWG, I_EWU, I_EWD };

struct Ctx {
    LAS unsigned char* lds; volatile LAS unsigned* MISC; volatile LAS int* TAB;
    unsigned* ctl; unsigned char* ws; const float* const* in; float* out;
    int tid, lane, wave, vcu;
};

__device__ __forceinline__ void transpose_item(const Ctx& F, const float* W, int Nsrc, int srccol, int k0, const float* kscale, bf16* dst, int dstK, int n0) {
    LAS float* s = (LAS float*)(F.lds + F.wave * 16640);
    const float mask = srccol >= 0 ? 1.f : 0.f; const int sc = srccol >= 0 ? srccol : 0;
    const float* src = W + (size_t)k0 * Nsrc + sc;
#pragma unroll 16
    for (int kk = 0; kk < 64; ++kk) s[kk * 65 + F.lane] = src[(size_t)kk * Nsrc] * mask;
    LDS_WAIT(); asm volatile("" ::: "memory");
    const int c = F.lane >> 3, nl = F.lane & 7;
    f32x4 ks0 = {1.f, 1.f, 1.f, 1.f}, ks1 = {1.f, 1.f, 1.f, 1.f};
    if (kscale) { ks0 = *(const f32x4*)(kscale + k0 + 8 * c); ks1 = *(const f32x4*)(kscale + k0 + 8 * c + 4); }
#pragma unroll
    for (int j = 0; j < 8; ++j) {
        const int n = nl + 8 * j; const LAS float* p = s + (8 * c) * 65 + n;
        u32x4 o; o.x = pk2(p[0] * ks0[0], p[65] * ks0[1]); o.y = pk2(p[130] * ks0[2], p[195] * ks0[3]); o.z = pk2(p[260] * ks1[0], p[325] * ks1[1]); o.w = pk2(p[390] * ks1[2], p[455] * ks1[3]);
        *(u32x4*)(dst + (size_t)(n0 + n) * dstK + k0 + 8 * c) = o;
    }
    LDS_WAIT(); asm volatile("" ::: "memory");
}

__device__ __forceinline__ void p0a(const Ctx& F) {
    const float* const* in = F.in;
    if ((int)blockIdx.x < 48) {
        const int l = blockIdx.x / 24, col0 = (blockIdx.x % 24) * 256;
        const float* c = in[I_C]; const float* wm = in[I_WMOD] + (size_t)l * 1024 * 6144;
        float sc[4][2];
#pragma unroll
        for (int b = 0; b < 4; ++b)
#pragma unroll
            for (int j = 0; j < 2; ++j) { const float v = c[b * 1024 + F.wave * 128 + j * 64 + F.lane]; sc[b][j] = v / (1.f + __expf(-v)); }
        f32x4 acc[4];
#pragma unroll
        for (int b = 0; b < 4; ++b) acc[b] = (f32x4){0.f, 0.f, 0.f, 0.f};
#pragma unroll
        for (int j = 0; j < 2; ++j) {
#pragma unroll 8
            for (int kk = 0; kk < 64; ++kk) {
                const f32x4 w4 = *(const f32x4*)(wm + (size_t)(F.wave * 128 + j * 64 + kk) * 6144 + col0 + 4 * F.lane);
#pragma unroll
                for (int b = 0; b < 4; ++b) { const float sv = lane_get(sc[b][j], kk); acc[b] += w4 * sv; }
            }
        }
        LAS float* red = (LAS float*)F.lds;
#pragma unroll
        for (int b = 0; b < 4; ++b) *(LAS f32x4*)(red + (F.wave * 4 + b) * 256 + 4 * F.lane) = acc[b];
        __syncthreads();
        float* MOD = (float*)(F.ws + WS_MOD);
        for (int idx = F.tid; idx < 1024; idx += 512) {
            const int b = idx >> 8, col = idx & 255; float s = in[I_BMOD][l * 6144 + col0 + col];
#pragma unroll
            for (int w = 0; w < 8; ++w) s += red[(w * 4 + b) * 256 + col];
            MOD[(size_t)(l * 4 + b) * 6144 + col0 + col] = s;
        }
        __syncthreads();
    }
    {
        const int idx = blockIdx.x * 512 + F.tid;
        if (idx < SEQ * 16) {
            const int pos = idx >> 4, i = idx & 15;
            double inv = 1.0; for (int j = 0; j < i; ++j) inv *= 0.56234132519034908039;
            const double ang = (double)pos * inv;
            const double TWO_PI_HI = 6.283185307179586232, TWO_PI_LO = 2.4492935982947064e-16;
            const double n = __builtin_rint(ang * 0.15915494309189533577);
            double r = __builtin_fma(-n, TWO_PI_HI, ang); r = __builtin_fma(-n, TWO_PI_LO, r);
            const double r2 = r * r; double sn = r, cs = 1.0, ts = r, tc = 1.0;
            for (int k = 1; k <= 14; ++k) { tc = -tc * r2 / (double)((2 * k - 1) * (2 * k)); cs += tc; ts = -ts * r2 / (double)((2 * k) * (2 * k + 1)); sn += ts; }
            ((f32x2*)(F.ws + WS_CS))[idx] = (f32x2){(float)cs, (float)sn};
        }
    }
    const int gw = F.vcu * NWAVES + F.wave, NGW = NBLK * NWAVES;
    for (int it = gw; it < 25600; it += NGW) {
        if (it < 1984) {
            const int l = it / 992; int r = it % 992;
            if (r < 640) {
                const int kb = r / 40, nb = r % 40, np = nb * 64 + F.lane; int sc;
                if (np < 1152) sc = np; else if (np < 1184) { const int i = np - 1152; sc = 2438 + (i >> 1) + 16 * (i & 1); } else if (np < 1190) sc = 1152 + (np - 1184); else if (np < 1280) sc = -1; else sc = 1158 + (np - 1280);
                transpose_item(F, in[I_WIN] + (size_t)l * 1024 * INW, INW, sc, kb * 64, nullptr, (bf16*)(F.ws + R_WIN) + (size_t)l * INP * 1024, 1024, nb * 64);
            } else if (r < 688) {
                r -= 640; const int kb = r / 12, nb = r % 12, np = nb * 64 + F.lane; int sc = -1;
                if (np < 576) { const int hh = np / 96, j = np % 96; if (j < 64) sc = hh * 96 + j; else { const int i = j - 64; sc = hh * 96 + 64 + (i >> 1) + 16 * (i & 1); } }
                transpose_item(F, in[I_WUQ] + (size_t)l * 256 * 576, 576, sc, kb * 64, in[I_QG] + l * 256, (bf16*)(F.ws + R_WUQ) + (size_t)l * 768 * 256, 256, nb * 64);
            } else if (r < 736) {
                r -= 688; const int kb = r / 12, nb = r % 12;
                transpose_item(F, in[I_WUKV] + (size_t)l * 256 * 768, 768, nb * 64 + F.lane, kb * 64, in[I_KVG] + l * 256, (bf16*)(F.ws + R_WUKV) + (size_t)l * 768 * 256, 256, nb * 64);
            } else {
                r -= 736; const int kb = r / 16, nb = r % 16;
                transpose_item(F, in[I_WO] + (size_t)l * 1024 * 1024, 1024, nb * 64 + F.lane, kb * 64, in[I_HG] + l * 1024, (bf16*)(F.ws + R_WO) + (size_t)l * 1024 * 1024, 1024, nb * 64);
            }
        } else if (it < 3392) {
            const int r = it - 1984, kb = r / 88, nb = r % 88, n0 = nb * 64, pn = n0 >> 8, j0 = n0 & 255;
            const float* W = j0 < 128 ? in[I_FWG] : in[I_FWU];
            transpose_item(F, W, DFF, pn * 128 + (j0 & 127) + F.lane, kb * 64, nullptr, (bf16*)(F.ws + R_WGU), 1024, n0);
        } else if (it < 4096) {
            const int r = it - 3392, kb = r / 16, nb = r % 16;
            transpose_item(F, in[I_FWD], 1024, nb * 64 + F.lane, kb * 64, nullptr, (bf16*)(F.ws + R_WD), DFF, nb * 64);
        } else {
            int r = it - 4096; const int e = r / 2688; r %= 2688;
            if (r < 1792) {
                const int kb = r / 112, nb = r % 112, n0 = nb * 64, pn = n0 >> 8, j0 = n0 & 255;
                const float* W = (j0 < 128 ? in[I_EWG] : in[I_EWU]) + (size_t)e * 1024 * DEXP;
                transpose_item(F, W, DEXP, pn * 128 + (j0 & 127) + F.lane, kb * 64, nullptr, (bf16*)(F.ws + WS_WEGU) + (size_t)e * 7168 * 1024, 1024, n0);
            } else {
                r -= 1792; const int kb = r / 16, nb = r % 16;
                transpose_item(F, in[I_EWD] + (size_t)e * DEXP * 1024, 1024, nb * 64 + F.lane, kb * 64, nullptr, (bf16*)(F.ws + WS_WED) + (size_t)e * 1024 * DEXP, DEXP, nb * 64);
            }
        }
    }
}

template <int MODE>
__device__ __forceinline__ void row_phase(const Ctx& F, int l, bool moe) {
    const float* MOD = (const float*)(F.ws + WS_MOD);
    const float* Y = (const float*)(F.ws + R_Y);
    float* RA = (float*)(F.ws + WS_RA);
    bf16* H = (bf16*)(F.ws + WS_H);
    volatile LAS int* lcnt = (volatile LAS int*)(F.lds);
    LAS int* rec = (LAS int*)(F.lds + 256);
    LAS float* recw = (LAS float*)(F.lds + 256 + 1024);
    const int rowb = blockIdx.x * 64;
    int start[8];
    if (MODE == 1 && moe) { if (F.tid < 16) lcnt[F.tid] = 0; __syncthreads(); }
    if (MODE == 2 && moe) { int s = 0;
#pragma unroll
        for (int e = 0; e < 8; ++e) { start[e] = s; s += (int)__hip_atomic_load(F.ctl + CW_CNT + 64 * e, RLX_AGENT); } }
    for (int rr = 0; rr < 8; ++rr) {
        const int rl = F.wave * 8 + rr, row = rowb + rl, b = row >> 12;
        const float* modb = MOD + (size_t)(l * 4 + b) * 6144;
        f32x4 v[4];
        if (MODE == 0) {
#pragma unroll
            for (int j = 0; j < 4; ++j) { const int c = 4 * F.lane + 256 * j; const f32x4 x = *(const f32x4*)(F.in[I_X] + (size_t)row * 1024 + c);
                const f32x4 sc = *(const f32x4*)(modb + 1024 + c), sh = *(const f32x4*)(modb + c); v[j] = x * (sc + 1.f) + sh; }
        } else {
            const float* res = MODE == 1 ? (l == 0 ? F.in[I_X] : F.out) : RA;
            const float* gate = modb + (MODE == 1 ? 2 : 5) * 1024;
            const float* lg = F.in[MODE == 1 ? I_LN1G : I_LN2G] + l * 1024; const float* lb = F.in[MODE == 1 ? I_LN1B : I_LN2B] + l * 1024;
            f32x4 y[4];
            if (MODE == 2 && moe) {
                const int p0 = ((const int*)(F.ws + WS_TOKP))[row * 2], p1 = ((const int*)(F.ws + WS_TOKP))[row * 2 + 1];
                const float w0 = ((const float*)(F.ws + WS_TOKW))[row * 2], w1 = ((const float*)(F.ws + WS_TOKW))[row * 2 + 1];
                const bf16* YR = (const bf16*)(F.ws + WS_WEGU);
                const size_t r0 = (size_t)(start[p0 >> 14] + (p0 & 16383)), r1 = (size_t)(start[p1 >> 14] + (p1 & 16383));
#pragma unroll
                for (int j = 0; j < 4; ++j) { const int c = 4 * F.lane + 256 * j; const u32x2 a = *(const u32x2*)(YR + r0 * 1024 + c), bq = *(const u32x2*)(YR + r1 * 1024 + c);
                    y[j] = (f32x4){bflo(a.x), bfhi(a.x), bflo(a.y), bfhi(a.y)} * w0 + (f32x4){bflo(bq.x), bfhi(bq.x), bflo(bq.y), bfhi(bq.y)} * w1; }
            } else {
#pragma unroll
                for (int j = 0; j < 4; ++j) y[j] = *(const f32x4*)(Y + (size_t)row * 1024 + 4 * F.lane + 256 * j);
            }
            float s = 0.f;
#pragma unroll
            for (int j = 0; j < 4; ++j) { const int c = 4 * F.lane + 256 * j; const f32x4 r4 = *(const f32x4*)(res + (size_t)row * 1024 + c), g4 = *(const f32x4*)(gate + c);
                v[j] = r4 * ALPHA + (g4 + 1.f) * y[j]; s += (v[j][0] + v[j][1]) + (v[j][2] + v[j][3]); }
            const float mean = wave_sum(s, F.lane) * (1.f / 1024.f); float q = 0.f;
#pragma unroll
            for (int j = 0; j < 4; ++j) { v[j] = v[j] - mean; q += (v[j][0] * v[j][0] + v[j][1] * v[j][1]) + (v[j][2] * v[j][2] + v[j][3] * v[j][3]); }
            const float rstd = 1.0f / sqrtf(wave_sum(q, F.lane) * (1.f / 1024.f) + LN_EPS);
            float* xo = MODE == 1 ? RA : F.out;
#pragma unroll
            for (int j = 0; j < 4; ++j) { const int c = 4 * F.lane + 256 * j; const f32x4 g4 = *(const f32x4*)(lg + c), b4 = *(const f32x4*)(lb + c);
                v[j] = v[j] * rstd * g4 + b4; *(f32x4*)(xo + (size_t)row * 1024 + c) = v[j]; }
            if (MODE == 2 && l == 1) continue;
            const float* modn = MODE == 1 ? modb + 3 * 1024 : MOD + (size_t)((l + 1) * 4 + b) * 6144;
#pragma unroll
            for (int j = 0; j < 4; ++j) { const int c = 4 * F.lane + 256 * j; const f32x4 sc = *(const f32x4*)(modn + 1024 + c), sh = *(const f32x4*)(modn + c); v[j] = v[j] * (sc + 1.f) + sh; }
        }
#pragma unroll
        for (int j = 0; j < 4; ++j) { u32x2 w; w.x = pk2(v[j][0], v[j][1]); w.y = pk2(v[j][2], v[j][3]); *(u32x2*)(H + (size_t)row * 1024 + 4 * F.lane + 256 * j) = w; }
        if (MODE == 1 && moe) {
            const float* rw = F.in[I_RW];
            float lg8[8];
#pragma unroll
            for (int e = 0; e < 8; ++e) lg8[e] = 0.f;
#pragma unroll
            for (int j = 0; j < 4; ++j)
#pragma unroll
                for (int i = 0; i < 4; ++i) { const int c = 4 * F.lane + 256 * j + i; const f32x4 wa = *(const f32x4*)(rw + (size_t)c * 8), wb = *(const f32x4*)(rw + (size_t)c * 8 + 4); const float hv = v[j][i];
                    lg8[0] += hv * wa[0]; lg8[1] += hv * wa[1]; lg8[2] += hv * wa[2]; lg8[3] += hv * wa[3]; lg8[4] += hv * wb[0]; lg8[5] += hv * wb[1]; lg8[6] += hv * wb[2]; lg8[7] += hv * wb[3]; }
#pragma unroll
            for (int e = 0; e < 8; ++e) lg8[e] = wave_sum(lg8[e], F.lane);
            int e0 = 0; float m0 = lg8[0];
#pragma unroll
            for (int e = 1; e < 8; ++e) if (lg8[e] > m0) { m0 = lg8[e]; e0 = e; }
            int e1 = -1; float m1 = -INFINITY;
#pragma unroll
            for (int e = 0; e < 8; ++e) if (e != e0 && lg8[e] > m1) { m1 = lg8[e]; e1 = e; }
            if (F.lane == 0) {
                const float ex = __expf(m1 - m0), w0 = 1.f / (1.f + ex), w1 = ex / (1.f + ex);
                const int k0 = __hip_atomic_fetch_add((LAS int*)(F.lds) + e0, 1, __ATOMIC_RELAXED, __HIP_MEMORY_SCOPE_WORKGROUP);
                const int k1 = __hip_atomic_fetch_add((LAS int*)(F.lds) + e1, 1, __ATOMIC_RELAXED, __HIP_MEMORY_SCOPE_WORKGROUP);
                rec[rl * 4 + 0] = e0; rec[rl * 4 + 1] = e1; rec[rl * 4 + 2] = k0; rec[rl * 4 + 3] = k1; recw[rl * 2] = w0; recw[rl * 2 + 1] = w1;
            }
        }
    }
    if (MODE == 1 && moe) {
        __syncthreads();
        if (F.tid < 8) lcnt[8 + F.tid] = (int)__hip_atomic_fetch_add(F.ctl + CW_CNT + 64 * F.tid, (unsigned)lcnt[F.tid], RLX_AGENT);
        __syncthreads();
        if (F.tid < 128) {
            const int rl = F.tid >> 1, k = F.tid & 1, e = rec[rl * 4 + k], pos = lcnt[8 + e] + rec[rl * 4 + 2 + k], row = rowb + rl;
            ((int*)(F.ws + WS_ROWL))[e * 16384 + pos] = row;
            ((int*)(F.ws + WS_TOKP))[row * 2 + k] = e * 16384 + pos;
            ((float*)(F.ws + WS_TOKW))[row * 2 + k] = recw[rl * 2 + k];
        }
        __syncthreads();
    }
}

__device__ __forceinline__ void scan_conv(const Ctx& F, int l) {
    const int gw = F.vcu * NWAVES + F.wave, NGW = NBLK * NWAVES;
    if (gw < 24) {
        const int b = gw / 6, h = gw % 6; const float* LOGF = (const float*)(F.ws + WS_LOGF); float* G = (float*)(F.ws + WS_G) + (size_t)gw * SEQ;
        float carry = 0.f;
        for (int j = 0; j < 64; ++j) {
            float v = LOGF[(size_t)(b * SEQ + j * 64 + F.lane) * 8 + h];
#pragma unroll
            for (int o = 1; o < 64; o <<= 1) { const float t = lane_get(v, F.lane - o); if (F.lane >= o) v += t; }
            v += carry; carry = lane_get(v, 63);
            G[j * 64 + F.lane] = -v * LOG2E;
        }
    }
    const bf16* C3 = (const bf16*)(F.ws + R_CONV3); bf16* OM = (bf16*)(F.ws + R_OM);
    const float* wc = F.in[I_WCONV] + l * 3 * 256;
    const f32x4 w0 = *(const f32x4*)(wc + 4 * F.lane), w1 = *(const f32x4*)(wc + 256 + 4 * F.lane), w2 = *(const f32x4*)(wc + 512 + 4 * F.lane);
    for (int m = gw; m < T; m += NGW) {
        const int t = m & (SEQ - 1);
        f32x4 cv = {0.f, 0.f, 0.f, 0.f};
#pragma unroll
        for (int d = 0; d < 3; ++d) {
            if (t - d >= 0) {
                const bf16* rp = C3 + (size_t)(m - d) * 768 + 4 * F.lane;
                const u32x2 cg = *(const u32x2*)(rp + 256), hi = *(const u32x2*)(rp + 512);
                const f32x4 u = (f32x4){bflo(cg.x) * bflo(hi.x), bfhi(cg.x) * bfhi(hi.x), bflo(cg.y) * bflo(hi.y), bfhi(cg.y) * bfhi(hi.y)};
                cv += u * (d == 0 ? w2 : (d == 1 ? w1 : w0));
            }
        }
        const u32x2 bg = *(const u32x2*)(C3 + (size_t)m * 768 + 4 * F.lane);
        f32x4 o = cv * (f32x4){bflo(bg.x), bfhi(bg.x), bflo(bg.y), bfhi(bg.y)};
        float s = (o[0] * o[0] + o[1] * o[1]) + (o[2] * o[2] + o[3] * o[3]);
        s += lane_xor(s, F.lane, 1); s += lane_xor(s, F.lane, 2); s += lane_xor(s, F.lane, 4); s += lane_xor(s, F.lane, 8);
        const float rstd = 1.0f / sqrtf(s * (1.f / 64.f) + RMS_EPS);
        o = o * rstd; u32x2 w; w.x = pk2(o[0], o[1]); w.y = pk2(o[2], o[3]);
        *(u32x2*)(OM + (size_t)m * 1024 + 384 + 4 * F.lane) = w;
    }
}

namespace att {
typedef short v4i16_t __attribute__((ext_vector_type(4)));
constexpr int KB0 = 0, KBSZ = 12288, VB0 = 2 * KBSZ, VBSZ = 8192, GB0 = VB0 + 2 * VBSZ, WSF0 = GB0 + 512, OST0 = WSF0 + 2048;
static_assert(OST0 + 8 * 8192 <= RING_BYTES, "attention LDS");
__device__ __forceinline__ int crow(int r, int hi) { return (r & 3) + 8 * (r >> 2) + 4 * hi; }
__device__ __forceinline__ s16x4 vtr(const LAS unsigned char* p) { return __builtin_bit_cast(s16x4, __builtin_amdgcn_ds_read_tr16_b64_v4i16((LAS v4i16_t*)p)); }

template <bool FOX>
__device__ __forceinline__ void unit(const Ctx& F, int b, int h, int qb) {
    constexpr int ND = FOX ? 4 : 6;
    const int lane = F.lane, wid = F.wave, r32 = lane & 31, hi = lane >> 5;
    const size_t rowbase = (size_t)b * SEQ; const int q0 = qb * 256;
    const bf16 *Qp, *Kp, *Vp; int qpitch, kpitch;
    if (FOX) { Qp = (const bf16*)(F.ws + R_FQ) + rowbase * 384 + h * 64; Kp = (const bf16*)(F.ws + R_FK) + rowbase * 384 + h * 64; Vp = (const bf16*)(F.ws + R_FV) + rowbase * 384 + h * 64; qpitch = 384; kpitch = 384; }
    else { Qp = (const bf16*)(F.ws + R_QM) + rowbase * 576 + h * 96; Kp = (const bf16*)(F.ws + R_KVM) + rowbase * 768 + h * 128; Vp = Kp + 64; qpitch = 576; kpitch = 768; }
    const bf16* KRp = (const bf16*)(F.ws + R_KR) + rowbase * 32;
    const float* Gp = (const float*)(F.ws + WS_G) + (size_t)(b * 6 + h) * SEQ;
    LAS unsigned char* lds = F.lds;
    LAS float* wsf = (LAS float*)(lds + WSF0) + wid * 64;
    LAS float* ost = (LAS float*)(lds + OST0 + wid * 8192);
    const int NT = (q0 + 256) / 64;
    bf16x8 qr[ND];
    { const bf16* Qw = Qp + (size_t)(q0 + wid * 32 + r32) * qpitch + hi * 8;
#pragma unroll
      for (int d0 = 0; d0 < ND; ++d0) qr[d0] = *(const bf16x8*)(Qw + d0 * 16); }
    u32x4 kreg0, kreg1 = {0u, 0u, 0u, 0u}, vreg; float greg = 0.f;
    const bf16* ksrc = Kp + (size_t)lane * kpitch + wid * 8;
    const bf16* krsrc = KRp + (size_t)lane * 32 + (wid & 3) * 8;
    const bf16* vsrc = Vp + (size_t)(16 * (wid & 3) + (lane >> 2)) * kpitch + (wid >> 2) * 32 + (lane & 3) * 8;
#define ATT_LOAD(t) do { kreg0 = *(const u32x4*)(ksrc + (size_t)(t) * 64 * kpitch); if (!FOX && wid < 4) kreg1 = *(const u32x4*)(krsrc + (size_t)(t) * 64 * 32); \
        vreg = *(const u32x4*)(vsrc + (size_t)(t) * 64 * kpitch); if (FOX && wid == 0) greg = Gp[(t) * 64 + lane]; } while (0)
#define ATT_STORE(buf) do { *(LAS u32x4*)(lds + KB0 + (buf) * KBSZ + wid * 1024 + lane * 16) = kreg0; if (!FOX && wid < 4) *(LAS u32x4*)(lds + KB0 + (buf) * KBSZ + (8 + wid) * 1024 + lane * 16) = kreg1; \
        *(LAS u32x4*)(lds + VB0 + (buf) * VBSZ + wid * 1024 + lane * 16) = vreg; if (FOX && wid == 0) *(LAS float*)(lds + GB0 + (buf) * 256 + lane * 4) = greg; } while (0)
    f32x16 o[2]; o[0] = f32x16{}; o[1] = f32x16{};
    float m_run = -INFINITY, l_run = 0.f;
    const int qmin = q0 + wid * 32, qabs = qmin + r32;
    ATT_LOAD(0); ATT_STORE(0);
    __syncthreads();
    for (int t = 0; t < NT; ++t) {
        const int buf = t & 1;
        if (t + 1 < NT) ATT_LOAD(t + 1);
        if (64 * t <= qmin + 31) {
            const LAS unsigned char* kb = lds + KB0 + buf * KBSZ + hi * 1024 + r32 * 16;
            f32x16 p0 = f32x16{}, p1 = f32x16{};
#pragma unroll
            for (int d0 = 0; d0 < ND; ++d0) {
                const bf16x8 k0f = *(const LAS bf16x8*)(kb + d0 * 2048), k1f = *(const LAS bf16x8*)(kb + d0 * 2048 + 512);
                p0 = __builtin_amdgcn_mfma_f32_32x32x16_bf16(k0f, qr[d0], p0, 0, 0, 0);
                p1 = __builtin_amdgcn_mfma_f32_32x32x16_bf16(k1f, qr[d0], p1, 0, 0, 0);
            }
            if (FOX) {
                const LAS float* gb = (const LAS float*)(lds + GB0 + buf * 256);
#pragma unroll
                for (int g = 0; g < 4; ++g) { const f32x4 a = *(const LAS f32x4*)(gb + 8 * g + 4 * hi), c = *(const LAS f32x4*)(gb + 32 + 8 * g + 4 * hi);
#pragma unroll
                    for (int j = 0; j < 4; ++j) { p0[4 * g + j] += a[j]; p1[4 * g + j] += c[j]; } }
            }
            if (64 * t + 63 > qmin) {
#pragma unroll
                for (int r = 0; r < 16; ++r) { const int kv = 64 * t + crow(r, hi); if (kv > qabs) p0[r] = -INFINITY; if (kv + 32 > qabs) p1[r] = -INFINITY; }
            }
            float mx = p0[0];
#pragma unroll
            for (int r = 1; r < 16; ++r) mx = fmaxf(mx, p0[r]);
#pragma unroll
            for (int r = 0; r < 16; ++r) mx = fmaxf(mx, p1[r]);
            mx = fmaxf(mx, lane_xor(mx, lane, 32));
            const float m_new = fmaxf(m_run, mx);
            const float alpha = __builtin_amdgcn_exp2f(m_run - m_new);
            m_run = m_new;
            float ls = 0.f;
#pragma unroll
            for (int r = 0; r < 16; ++r) { p0[r] = __builtin_amdgcn_exp2f(p0[r] - m_new); p1[r] = __builtin_amdgcn_exp2f(p1[r] - m_new); ls += p0[r] + p1[r]; }
            l_run = l_run * alpha + ls;
            if (hi == 0) wsf[r32] = alpha;
            LDS_WAIT();
#pragma unroll
            for (int g = 0; g < 4; ++g) { const f32x4 a = *(const LAS f32x4*)(wsf + 8 * g + 4 * hi);
#pragma unroll
                for (int j = 0; j < 4; ++j) { o[0][4 * g + j] *= a[j]; o[1][4 * g + j] *= a[j]; } }
            u32x4 pw[4];
#pragma unroll
            for (int s = 0; s < 2; ++s) {
                pw[s] = (u32x4){pk2(p0[8 * s], p0[8 * s + 1]), pk2(p0[8 * s + 2], p0[8 * s + 3]), pk2(p0[8 * s + 4], p0[8 * s + 5]), pk2(p0[8 * s + 6], p0[8 * s + 7])};
                pw[2 + s] = (u32x4){pk2(p1[8 * s], p1[8 * s + 1]), pk2(p1[8 * s + 2], p1[8 * s + 3]), pk2(p1[8 * s + 4], p1[8 * s + 5]), pk2(p1[8 * s + 6], p1[8 * s + 7])};
            }
            const LAS unsigned char* vb = lds + VB0 + buf * VBSZ + ((lane >> 4) & 1) * 32 + (lane & 3) * 8 + (4 * hi + ((lane & 15) >> 2)) * 64;
#pragma unroll
            for (int d0 = 0; d0 < 2; ++d0)
#pragma unroll
                for (int ks = 0; ks < 4; ++ks) {
                    const s16x4 lo = vtr(vb + d0 * 4096 + ks * 1024), hh = vtr(vb + d0 * 4096 + ks * 1024 + 512);
                    const bf16x8 vf = (bf16x8){lo[0], lo[1], lo[2], lo[3], hh[0], hh[1], hh[2], hh[3]};
                    o[d0] = __builtin_amdgcn_mfma_f32_32x32x16_bf16(__builtin_bit_cast(bf16x8, pw[ks]), vf, o[d0], 0, 0, 0);
                }
        }
        if (t + 1 < NT) ATT_STORE(buf ^ 1);
        __syncthreads();
    }
#undef ATT_LOAD
#undef ATT_STORE
    float lt = l_run + lane_xor(l_run, lane, 32);
    if (hi == 0) wsf[r32] = 1.0f / lt;
    LDS_WAIT();
#pragma unroll
    for (int g = 0; g < 4; ++g) { const f32x4 a = *(const LAS f32x4*)(wsf + 8 * g + 4 * hi);
#pragma unroll
        for (int j = 0; j < 4; ++j) { ost[crow(4 * g + j, hi) * 64 + r32] = o[0][4 * g + j] * a[j]; ost[crow(4 * g + j, hi) * 64 + 32 + r32] = o[1][4 * g + j] * a[j]; } }
    LDS_WAIT();
    bf16* OM = (bf16*)(F.ws + R_OM) + (rowbase + q0 + wid * 32) * 1024 + (FOX ? h * 64 : 640 + h * 64);
#pragma unroll
    for (int i = 0; i < 4; ++i) {
        const int row = i * 8 + (lane >> 3), ch = lane & 7;
        const f32x4 a = *(const LAS f32x4*)(ost + row * 64 + ch * 8), c = *(const LAS f32x4*)(ost + row * 64 + ch * 8 + 4);
        float s = (a[0] * a[0] + a[1] * a[1]) + (a[2] * a[2] + a[3] * a[3]) + (c[0] * c[0] + c[1] * c[1]) + (c[2] * c[2] + c[3] * c[3]);
        s += lane_xor(s, lane, 1); s += lane_xor(s, lane, 2); s += lane_xor(s, lane, 4);
        const float rstd = 1.0f / sqrtf(s * (1.f / 64.f) + RMS_EPS);
        u32x4 w; w.x = pk2(a[0] * rstd, a[1] * rstd); w.y = pk2(a[2] * rstd, a[3] * rstd); w.z = pk2(c[0] * rstd, c[1] * rstd); w.w = pk2(c[2] * rstd, c[3] * rstd);
        *(u32x4*)(OM + (size_t)row * 1024 + ch * 8) = w;
    }
    LDS_WAIT();
}

__device__ __forceinline__ void phase(const Ctx& F, int l) {
    unsigned* ctr = F.ctl + CW_AQ + 64 * l;
    for (;;) {
        if (F.tid == 0) F.MISC[4] = __hip_atomic_fetch_add(ctr, 1u, RLX_AGENT);
        __syncthreads();
        const int u = (int)F.MISC[4];
        __syncthreads();
        if (u >= 768) break;
        const int qb = 15 - u / 48, rem = u % 48, type = rem / 24, bh = rem % 24, b = bh / 6, h = bh % 6;
        if (type == 0) unit<false>(F, b, h, qb); else unit<true>(F, b, h, qb);
    }
}
}

__device__ __forceinline__ void moe_tables(const Ctx& F, int nN) {
    if (F.tid == 0) { int s = 0, up = 0;
        for (int e = 0; e < 8; ++e) { const int c = (int)__hip_atomic_load(F.ctl + CW_CNT + 64 * e, RLX_AGENT), nM = (c + 255) >> 8; F.TAB[e] = c; F.TAB[8 + e] = s; F.TAB[16 + e] = up; F.TAB[25 + e] = nM; s += c; up += nM * nN; }
        F.TAB[24] = up; }
    __syncthreads();
}

__global__ void __launch_bounds__(NWAVES * 64, 2) mk_fwd(Args args) {
    extern __shared__ __attribute__((aligned(16))) unsigned char lds_raw[];
    Ctx F;
    F.lds = (LAS unsigned char*)lds_raw; F.MISC = (volatile LAS unsigned*)(F.lds + MISC_OFF); F.TAB = (volatile LAS int*)(F.lds + TAB_OFF);
    F.tid = threadIdx.x; F.lane = F.tid & 63; F.wave = __builtin_amdgcn_readfirstlane(F.tid >> 6);
    { const int bx = blockIdx.x; F.vcu = (bx % 8) * (NBLK / 8) + bx / 8; }
    F.ws = args.ws; F.ctl = (unsigned*)(args.ws + WS_CTL); F.in = args.in; F.out = args.out;
    for (int u = F.tid; u < (LDS_BYTES - SCR_BYTES) / 4; u += NWAVES * 64) ((LAS unsigned*)(F.lds + SCR_BYTES))[u] = 0u;
    __syncthreads();
    const int lo = args.ph_lo, hi = args.ph_hi;
    XcdBarrier bar; bar.bar = F.ctl + CW_BAR; bar.x = 0; bar.st = nullptr;
    if (hi - lo > 1) bar = xcd_barrier_post(F.ctl + CW_BAR, F.MISC + 8);
    const int G = NBLK, cb = (int)blockIdx.x;

    for (int ph = lo; ph < hi; ++ph) {
        { int t_ = threadIdx.x; asm volatile("" : "+v"(t_)); F.tid = t_; F.lane = t_ & 63; F.wave = __builtin_amdgcn_readfirstlane(t_ >> 6); }
        if (ph == 0) { if (PHM(8)) p0a(F); }
        else if (ph == 1) { if (PHM(9)) row_phase<0>(F, 0, false); }
        else {
            const int l = (ph - 2) >> 3, s = (ph - 2) & 7; const bool moe = (l == 1);
            if (s == 0 && PHM(0)) {
                g8::SchedPlain S{(const char*)(F.ws + WS_H), (const char*)(F.ws + R_WIN) + (size_t)l * INP * 1024 * 2, T / 256, INP / 256, 1024, G, cb};
                g8::EpiIn E{(bf16*)(F.ws + R_FQ), (bf16*)(F.ws + R_FK), (bf16*)(F.ws + R_FV), (bf16*)(F.ws + R_KR), (bf16*)(F.ws + R_CONV3), (bf16*)(F.ws + R_CQ), (bf16*)(F.ws + R_CKV),
                            (float*)(F.ws + WS_LOGF), (float*)(F.ws + WS_SSQ), F.in[I_BF] + l * 6, (const f32x2*)(F.ws + WS_CS)};
                g8::gemm_phase<g8::EpiIn, g8::SchedPlain, false>(F.lds, F.tid, 1024, S, E);
            } else if (s == 1 && PHM(1)) {
#ifndef NO_SCANCONV
                scan_conv(F, l);
#endif
                { int t_ = threadIdx.x; asm volatile("" : "+v"(t_)); F.tid = t_; F.lane = t_ & 63; }
                { g8::SchedPlain S{(const char*)(F.ws + R_CQ), (const char*)(F.ws + R_WUQ) + (size_t)l * 768 * 256 * 2, T / 256, 3, 256, G, cb};
                  g8::EpiUp<0> E{(bf16*)(F.ws + R_QM), (bf16*)(F.ws + R_KVM), (const float*)(F.ws + WS_SSQ), (const f32x2*)(F.ws + WS_CS)};
                  g8::gemm_phase<g8::EpiUp<0>, g8::SchedPlain, false>(F.lds, F.tid, 256, S, E); }
                { int t_ = threadIdx.x; asm volatile("" : "+v"(t_)); F.tid = t_; F.lane = t_ & 63; }
                { g8::SchedPlain S{(const char*)(F.ws + R_CKV), (const char*)(F.ws + R_WUKV) + (size_t)l * 768 * 256 * 2, T / 256, 3, 256, G, (cb + 128) & 255};
                  g8::EpiUp<1> E{(bf16*)(F.ws + R_QM), (bf16*)(F.ws + R_KVM), (const float*)(F.ws + WS_SSQ), (const f32x2*)(F.ws + WS_CS)};
                  g8::gemm_phase<g8::EpiUp<1>, g8::SchedPlain, false>(F.lds, F.tid, 256, S, E); }
            } else if (s == 2 && PHM(2)) {
                att::phase(F, l);
            } else if (s == 3 && PHM(3)) {
                g8::SchedPlain S{(const char*)(F.ws + R_OM), (const char*)(F.ws + R_WO) + (size_t)l * 1024 * 1024 * 2, T / 256, 4, 1024, G, cb};
                g8::EpiF32 E{(float*)(F.ws + R_Y), 1024};
                g8::gemm_phase<g8::EpiF32, g8::SchedPlain, false>(F.lds, F.tid, 1024, S, E);
            } else if (s == 4 && PHM(4)) {
                row_phase<1>(F, l, moe);
            } else if (s == 5) {
                if (!moe) { if (PHM(5)) {
                    g8::SchedPlain S{(const char*)(F.ws + WS_H), (const char*)(F.ws + R_WGU), T / 256, 2 * DFF / 256, 1024, G, cb};
                    g8::EpiSwiGLU E{(bf16*)(F.ws + R_ACT), DFF};
                    g8::gemm_phase<g8::EpiSwiGLU, g8::SchedPlain, false>(F.lds, F.tid, 1024, S, E); }
                } else if (PHM(10)) {
                    moe_tables(F, 2 * DEXP / 256);
                    g8::SchedMoE S{(const char*)(F.ws + WS_H), (const char*)(F.ws + WS_WEGU), (size_t)7168 * 1024 * 2, (const int*)(F.ws + WS_ROWL), F.TAB, 2 * DEXP / 256, 1024, G, cb, true};
                    g8::EpiSwiGLU E{(bf16*)(F.ws + R_ACTM), DEXP};
                    g8::gemm_phase<g8::EpiSwiGLU, g8::SchedMoE, true>(F.lds, F.tid, 1024, S, E);
                }
            } else if (s == 6) {
                if (!moe) { if (PHM(6)) {
                    g8::SchedPlain S{(const char*)(F.ws + R_ACT), (const char*)(F.ws + R_WD), T / 256, 4, DFF, G, cb};
                    g8::EpiF32 E{(float*)(F.ws + R_Y), 1024};
                    g8::gemm_phase<g8::EpiF32, g8::SchedPlain, false>(F.lds, F.tid, DFF, S, E); }
                } else if (PHM(11)) {
                    moe_tables(F, 4);
                    g8::SchedMoE S{(const char*)(F.ws + R_ACTM), (const char*)(F.ws + WS_WED), (size_t)1024 * DEXP * 2, (const int*)(F.ws + WS_ROWL), F.TAB, 4, DEXP, G, cb, false};
                    g8::EpiBf16Rows E{(bf16*)(F.ws + WS_WEGU), 1024};
                    g8::gemm_phase<g8::EpiBf16Rows, g8::SchedMoE, false>(F.lds, F.tid, DEXP, S, E);
                }
            } else if (s == 7 && PHM(7)) {
                row_phase<2>(F, l, moe);
            }
        }
        if (ph + 1 < hi) xcd_barrier(bar);
    }
}

constexpr int N_PHASES = 18;
extern "C" void kernel_launch(void* const* d_in, const int* in_sizes, int n_in, void* d_out, int out_size, void* d_ws, size_t ws_size, hipStream_t stream) {
    static int ready = 0;
    if (ready == 0) {
        if (n_in != 24 || out_size != T * DM || ws_size < WS_END) { fprintf(stderr, "kernel_launch: unexpected problem (n_in %d, out %d, ws %zu < %zu)\n", n_in, out_size, ws_size, (size_t)WS_END); ready = -1; return; }
        if (hipFuncSetAttribute((const void*)mk_fwd, hipFuncAttributeMaxDynamicSharedMemorySize, LDS_BYTES) != hipSuccess) { fprintf(stderr, "kernel_launch: hipFuncSetAttribute failed\n"); ready = -1; return; }
        int per_cu = 0;
        if (hipOccupancyMaxActiveBlocksPerMultiprocessor(&per_cu, (const void*)mk_fwd, NWAVES * 64, LDS_BYTES) != hipSuccess || per_cu < 1) fprintf(stderr, "kernel_launch: occupancy query reports %d\n", per_cu);
        (void)hipGetLastError();
        ready = 1;
    }
    if (ready < 0) return;
    (void)hipMemsetAsync((char*)d_ws + WS_CTL, 0, CTL_ZERO_BYTES, stream);
    Args a{};
    for (int i = 0; i < 24; ++i) a.in[i] = (const float*)d_in[i];
    a.out = (float*)d_out; a.ws = (unsigned char*)d_ws;
#if MK_N_LAUNCHES == 1
    a.ph_lo = 0; a.ph_hi = N_PHASES;
    hipLaunchKernelGGL(mk_fwd, dim3(NBLK), dim3(NWAVES * 64), LDS_BYTES, stream, a);
#else
    for (int p = 0; p < N_PHASES; ++p) { a.ph_lo = p; a.ph_hi = p + 1; hipLaunchKernelGGL(mk_fwd, dim3(NBLK), dim3(NWAVES * 64), LDS_BYTES, stream, a); }
#endif
}
```

```cpp
#include <hip/hip_runtime.h>
#include <cstdio>
#include <cstdint>

#ifndef MK_N_LAUNCHES
#define MK_N_LAUNCHES 1
#endif

#ifndef PH_MASK
#define PH_MASK 0xFFF
#endif
#define PHM(k) ((PH_MASK >> (k)) & 1)
#ifndef REP_MASK
#define REP_MASK 0
#endif
#define LAS __attribute__((address_space(3)))
typedef unsigned short bf16;
typedef short bf16x8 __attribute__((ext_vector_type(8)));
typedef short s16x4 __attribute__((ext_vector_type(4)));
typedef float f32x2 __attribute__((ext_vector_type(2)));
typedef float f32x4 __attribute__((ext_vector_type(4)));
typedef float f32x16 __attribute__((ext_vector_type(16)));
typedef unsigned u32x2 __attribute__((ext_vector_type(2)));
typedef unsigned u32x4 __attribute__((ext_vector_type(4)));
typedef __bf16 bf16x2_t __attribute__((ext_vector_type(2)));

constexpr int DM = 1024, NBATCH = 4, SEQ = 4096, T = NBATCH * SEQ;
constexpr int HF = 6, HM = 6;
constexpr int INW = 2470, INP = 2560;
constexpr int DFF = 2816, NE = 8, DEXP = 3584;
constexpr int NBLK = 256, NWAVES = 8;
constexpr float LOG2E = 1.4426950408889634f;
constexpr float C2F = 0.125f * LOG2E;
constexpr float C2M = 0.10206207261596575f * LOG2E;
constexpr float ALPHA = 1.4142135623730951f;
constexpr float LN_EPS = 1e-5f, RMS_EPS = 1e-6f;

constexpr size_t MiB = 1u << 20, KiB = 1024;
constexpr size_t WS_CTL = 0, CTL_ZERO_BYTES = 1 * MiB;
constexpr size_t WS_MOD = 1 * MiB;
constexpr size_t WS_CS = WS_MOD + 256 * KiB;
constexpr size_t WS_G = WS_CS + 512 * KiB;
constexpr size_t WS_LOGF = WS_G + 512 * KiB;
constexpr size_t WS_SSQ = WS_LOGF + 512 * KiB;
constexpr size_t WS_ROWL = WS_SSQ + 512 * KiB;
constexpr size_t WS_TOKP = WS_ROWL + 512 * KiB;
constexpr size_t WS_TOKW = WS_TOKP + 128 * KiB;
constexpr size_t WS_WEGU = 8 * MiB;
constexpr size_t WS_WED = 120 * MiB;
constexpr size_t WS_RA = 176 * MiB;
constexpr size_t WS_H = 240 * MiB;
constexpr size_t WS_R = 272 * MiB;
constexpr size_t WS_END = 498 * MiB;
constexpr size_t R_WIN = WS_R, R_WUQ = WS_R + 10 * MiB, R_WUKV = R_WUQ + 768 * KiB, R_WO = R_WUKV + 768 * KiB, R_WGU = R_WO + 4 * MiB, R_WD = R_WGU + 11 * MiB;
constexpr size_t R_Y = WS_R + 32 * MiB;
constexpr size_t R_CONV3 = WS_R + 32 * MiB, R_CQ = WS_R + 56 * MiB, R_CKV = WS_R + 64 * MiB, R_QM = WS_R + 72 * MiB, R_KVM = WS_R + 90 * MiB, R_OM = WS_R + 114 * MiB;
constexpr size_t R_FQ = WS_R + 146 * MiB, R_FK = WS_R + 158 * MiB, R_FV = WS_R + 170 * MiB, R_KR = WS_R + 182 * MiB;
constexpr size_t R_ACT = WS_R + 96 * MiB;
constexpr size_t R_ACTM = WS_R;
static_assert(R_WD + (size_t)DM * DFF * 2 <= R_Y, "weights fit");
static_assert(R_ACT + (size_t)T * DFF * 2 <= WS_END && R_ACTM + (size_t)(32768 + 256) * DEXP * 2 <= WS_END, "act fits");
constexpr int CW_BAR = 4096, CW_CNT = 8192, CW_AQ = 9216;

constexpr int RING_BYTES = 131072, SCR_BYTES = 135168  , MISC_OFF = SCR_BYTES + 320, TAB_OFF = SCR_BYTES + 1024, LDS_BYTES = 147456;
static_assert(8 * 16640 <= SCR_BYTES, "prologue scratch");

__device__ __forceinline__ unsigned pk2(float lo, float hi) { f32x2 v = {lo, hi}; bf16x2_t b = __builtin_convertvector(v, bf16x2_t); return __builtin_bit_cast(unsigned, b); }
__device__ __forceinline__ float bflo(unsigned u) { return __uint_as_float(u << 16); }
__device__ __forceinline__ float bfhi(unsigned u) { return __uint_as_float(u & 0xffff0000u); }
__device__ __forceinline__ float lane_get(float v, int src) { return __int_as_float(__builtin_amdgcn_ds_bpermute(src << 2, __float_as_int(v))); }
__device__ __forceinline__ float lane_xor(float v, int lane, int o) { return lane_get(v, lane ^ o); }
__device__ __forceinline__ float wave_sum(float v, int lane) {
#pragma unroll
    for (int o = 1; o < 64; o <<= 1) v += lane_xor(v, lane, o);
    return v;
}
#define LDS_WAIT() asm volatile("s_waitcnt lgkmcnt(0)" ::: "memory")
#define VM_WAIT() asm volatile("s_waitcnt vmcnt(0)" ::: "memory")
#define RLX_AGENT __ATOMIC_RELAXED, __HIP_MEMORY_SCOPE_AGENT

namespace g8 {
constexpr int BM = 256, BK = 64, HALF = 128, HTB = HALF * BK * 2, STAGE_BYTES = 8 * HTB, NXCD = 8, WGM = 8;
__host__ __device__ __forceinline__ int lds_byte(int r, int c) { const int st = (r >> 4) * 2 + (c >> 5), rr = r & 15, cc = c & 31, ob = rr * 64 + cc * 2; return st * 1024 + (ob ^ (((ob >> 9) & 1) << 5)); }
__host__ __device__ __forceinline__ void stage_rc(int b, int& R, int& C) { const int st = b / 1024, sb = b % 1024, swz = sb ^ (((sb >> 9) & 1) << 5); R = (st >> 1) * 16 + swz / 64; C = (st & 1) * 32 + (swz % 64) / 2; }
__host__ __device__ __forceinline__ int perm32(int rho) { const int n = rho >> 4, i = rho & 15; return 8 * (i >> 2) + 4 * n + (i & 3); }

struct Unit { int pm, pn, grp, mvalid, rowbase; const char* a; const char* b; const int* rl; };

__device__ __forceinline__ int xcd_remap(int wgid, int nwg) { const int q = nwg / NXCD, r = nwg % NXCD, xcd = wgid % NXCD, off = wgid / NXCD; return (xcd < r ? xcd * (q + 1) : r * (q + 1) + (xcd - r) * q) + off; }
__device__ __forceinline__ void grouped_pmpn(int local, int nM, int nN, int& pm, int& pn) {
    const int nig = WGM * nN, gid = local / nig, fm = gid * WGM, gsz = (nM - fm) < WGM ? (nM - fm) : WGM;
    pm = fm + ((local % nig) % gsz); pn = (local % nig) / gsz;
}
struct SchedPlain {
    const char* A; const char* Bt; int nM, nN, K, G, c;
    __device__ __forceinline__ bool next(int i, Unit& u) const {
        const int nwg = nM * nN; const long L = (long)i * G + c; if (L >= nwg) return false;
        const int wgid = xcd_remap((int)L, nwg); int pm, pn; grouped_pmpn(wgid, nM, nN, pm, pn);
        u.pm = pm; u.pn = pn; u.grp = 0; u.mvalid = 256; u.rowbase = pm * 256; u.a = A + (size_t)pm * 256 * K * 2; u.b = Bt + (size_t)pn * 256 * K * 2; u.rl = nullptr; return true;
    }
};
struct SchedPair {
    const char* A0; const char* B0; const char* A1; const char* B1; int nM, nN, K, G, c;
    __device__ __forceinline__ bool next(int i, Unit& u) const {
        const int per = nM * nN, nwg = 2 * per; const long L = (long)i * G + c; if (L >= nwg) return false;
        const int wgid = xcd_remap((int)L, nwg); const int grp = wgid / per; int pm, pn; grouped_pmpn(wgid % per, nM, nN, pm, pn);
        u.pm = pm; u.pn = pn; u.grp = grp; u.mvalid = 256; u.rowbase = pm * 256;
        u.a = (grp ? A1 : A0) + (size_t)pm * 256 * K * 2; u.b = (grp ? B1 : B0) + (size_t)pn * 256 * K * 2; u.rl = nullptr; return true;
    }
};
struct SchedMoE {
    const char* A; const char* Bt; size_t bexp; const int* rowl; volatile LAS int* tab; int nN, K, G, c; bool gather;
    __device__ __forceinline__ int tb(int i) const { return __builtin_amdgcn_readfirstlane(tab[i]); }
    __device__ __forceinline__ bool next(int i, Unit& u) const {
        const int nwg = tb(24); const long L = (long)i * G + c; if (L >= nwg) return false;
        const int wgid = xcd_remap((int)L, nwg);
        int e = 0;
#pragma unroll
        for (int j = 1; j < 8; ++j) if (wgid >= tb(16 + j)) e = j;
        const int local = wgid - tb(16 + e), nM = tb(25 + e), cnt = tb(e), start = tb(8 + e);
        int pm, pn; grouped_pmpn(local, nM, nN, pm, pn);
        u.pm = pm; u.pn = pn; u.grp = e; u.mvalid = (cnt - pm * 256) < 256 ? (cnt - pm * 256) : 256; u.rowbase = start + pm * 256;
        u.a = gather ? A : A + (size_t)(start + pm * 256) * K * 2; u.b = Bt + (size_t)e * bexp + (size_t)pn * 256 * K * 2; u.rl = rowl + e * 16384 + pm * 256; return true;
    }
};

template <class Epi, class Sched, bool GATHER>
__device__ __forceinline__ void gemm_phase(LAS unsigned char* lds, const int tid, const int K, const Sched& S, const Epi& E) {
    const int wid = __builtin_amdgcn_readfirstlane(tid >> 6), lane = tid & 63, wr = wid >> 2, wc = wid & 3, fr = lane & 15, fq = lane >> 4;
    const int nt = K / BK;
    int RA[2], CA[2]; unsigned voffB[2];
#pragma unroll
    for (int i = 0; i < 2; ++i) { int R, C; stage_rc(tid * 16 + i * 8192, R, C); const int Rb = Epi::PERM ? ((R & ~31) + perm32(R & 31)) : R; RA[i] = R; CA[i] = C; voffB[i] = (unsigned)(Rb * K + C) * 2u; }
    const size_t kstep = (size_t)(BK * 2);
    const size_t hstep = (size_t)HALF * K * 2;
    const unsigned ldsw = (unsigned)wid * 1024u;
    const int aoff = lds_byte(wr * 64 + fr, fq * 8), boff = lds_byte(wc * 32 + fr, fq * 8);
#define G8_SA(b, h) (((b) * 2 + (h)) * HTB)
#define G8_SB(b, h) ((4 + (b) * 2 + (h)) * HTB)
#define G8_STAGE_B(bufoff, gbase) do { _Pragma("unroll") for (int _i = 0; _i < 2; ++_i) \
        __builtin_amdgcn_global_load_lds((const unsigned*)((const char*)(gbase) + voffB[_i]), (LAS unsigned*)(lds + (bufoff) + ldsw + _i * 8192), 16, 0, 0); } while (0)
#define G8_STAGE_A(bufoff, gbase, AO, h) do { _Pragma("unroll") for (int _i = 0; _i < 2; ++_i) \
        __builtin_amdgcn_global_load_lds((const unsigned*)((const char*)(gbase) + AO[h][_i]), (LAS unsigned*)(lds + (bufoff) + ldsw + _i * 8192), 16, 0, 0); } while (0)
#define G8_LDA(dst, b, h) do { _Pragma("unroll") for (int m = 0; m < 4; ++m) _Pragma("unroll") for (int k = 0; k < 2; ++k) dst[m][k] = *(const LAS bf16x8*)(lds + G8_SA(b, h) + aoff + m * 2048 + k * 1024); } while (0)
#define G8_LDB(dst, b, h) do { _Pragma("unroll") for (int n = 0; n < 2; ++n) _Pragma("unroll") for (int k = 0; k < 2; ++k) dst[n][k] = *(const LAS bf16x8*)(lds + G8_SB(b, h) + boff + n * 2048 + k * 1024); } while (0)
#define G8_MMA(ai, bj, At, Bt) do { __builtin_amdgcn_s_setprio(1); _Pragma("unroll") for (int m = 0; m < 4; ++m) _Pragma("unroll") for (int n = 0; n < 2; ++n) _Pragma("unroll") for (int k = 0; k < 2; ++k) \
        acc[ai][bj][m][n] = __builtin_amdgcn_mfma_f32_16x16x32_bf16(Bt[n][k], At[m][k], acc[ai][bj][m][n], 0, 0, 0); __builtin_amdgcn_s_setprio(0); } while (0)
#define G8_WAIT_V(n) asm volatile("s_waitcnt vmcnt(" #n ")" ::: "memory")
#define G8_WAIT_L(n) asm volatile("s_waitcnt lgkmcnt(" #n ")" ::: "memory")
#define G8_BAR __builtin_amdgcn_s_barrier()
#define G8_SCHED __builtin_amdgcn_sched_barrier(0)
#define G8_AOFF(AO, U) do { _Pragma("unroll") for (int _h = 0; _h < 2; ++_h) _Pragma("unroll") for (int _i = 0; _i < 2; ++_i) { \
        if constexpr (GATHER) { const int _r = _h * HALF + RA[_i]; const int _tok = (_r < (U).mvalid) ? (U).rl[_r] : 0; AO[_h][_i] = (unsigned)_tok * (unsigned)(K * 2) + (unsigned)(CA[_i] * 2); } \
        else AO[_h][_i] = (unsigned)((_h * HALF + RA[_i]) * K + CA[_i]) * 2u; } } while (0)
    Unit cur, nxt; int ui = 0;
    if (!S.next(0, cur)) return;
    f32x4 acc[2][2][4][2];
#pragma unroll
    for (int a = 0; a < 2; ++a)
#pragma unroll
        for (int b = 0; b < 2; ++b)
#pragma unroll
            for (int m = 0; m < 4; ++m)
#pragma unroll
                for (int n = 0; n < 2; ++n) acc[a][b][m][n] = (f32x4){0.f, 0.f, 0.f, 0.f};
    bf16x8 At[4][2], B0[2][2], B1[2][2];
    unsigned aoc[2][2], aon[2][2];
    G8_AOFF(aoc, cur);
    if constexpr (GATHER) { VM_WAIT(); }
    const char* cA = cur.a; const char* cB = cur.b;
    G8_STAGE_B(G8_SB(0, 0), cB); G8_STAGE_B(G8_SB(0, 1), cB + hstep); G8_STAGE_A(G8_SA(0, 0), cA, aoc, 0); G8_STAGE_A(G8_SA(0, 1), cA, aoc, 1);
    if (wr == 1) G8_BAR;
    G8_WAIT_V(2); G8_BAR;
    G8_STAGE_B(G8_SB(1, 0), cB + kstep); G8_STAGE_A(G8_SA(1, 0), cA + kstep, aoc, 0); G8_STAGE_B(G8_SB(1, 1), cB + hstep + kstep);
    G8_WAIT_V(6); G8_BAR;
    for (;;) {
        const bool has_next = S.next(ui + 1, nxt);
        const char* nA = has_next ? nxt.a : cA; const char* nB = has_next ? nxt.b : cB;
        if constexpr (GATHER) {
            if (has_next) { G8_AOFF(aon, nxt); }
            else {
#pragma unroll
                for (int h = 0; h < 2; ++h)
#pragma unroll
                    for (int i = 0; i < 2; ++i) aon[h][i] = aoc[h][i];
            }
        }
#pragma unroll 1
        for (int t = 0; t < nt; t += 2) {
            const bool last = (t == nt - 2);
            const char* a1 = cA + (size_t)(t + 1) * kstep;
            const char* a2 = last ? nA : cA + (size_t)(t + 2) * kstep; const char* b2 = last ? nB : cB + (size_t)(t + 2) * kstep;
            const char* a3 = a2 + kstep; const char* b3 = b2 + kstep;
            unsigned ao2[2][2];
#pragma unroll
            for (int h = 0; h < 2; ++h)
#pragma unroll
                for (int i = 0; i < 2; ++i) { if constexpr (GATHER) ao2[h][i] = last ? aon[h][i] : aoc[h][i]; else ao2[h][i] = aoc[h][i]; }
            G8_LDB(B0, 0, 0); G8_LDB(B1, 0, 1); G8_SCHED; G8_LDA(At, 0, 0); G8_STAGE_A(G8_SA(1, 1), a1, aoc, 1);
            G8_WAIT_V(8); G8_WAIT_L(0); G8_BAR; G8_MMA(0, 0, At, B0); G8_MMA(0, 1, At, B1); G8_BAR; G8_SCHED;
            G8_LDA(At, 0, 1); G8_STAGE_B(G8_SB(0, 0), b2); G8_STAGE_B(G8_SB(0, 1), b2 + hstep); G8_STAGE_A(G8_SA(0, 0), a2, ao2, 0);
            G8_WAIT_V(8); G8_WAIT_L(0); G8_BAR; G8_MMA(1, 0, At, B0); G8_MMA(1, 1, At, B1); G8_BAR; G8_SCHED;
            G8_LDB(B0, 1, 0); G8_LDB(B1, 1, 1); G8_SCHED; G8_LDA(At, 1, 0); G8_STAGE_A(G8_SA(0, 1), a2, ao2, 1);
            G8_WAIT_V(8); G8_WAIT_L(0); G8_BAR; G8_MMA(0, 0, At, B0); G8_MMA(0, 1, At, B1); G8_BAR; G8_SCHED;
            G8_LDA(At, 1, 1); G8_STAGE_B(G8_SB(1, 0), b3); G8_STAGE_B(G8_SB(1, 1), b3 + hstep); G8_STAGE_A(G8_SA(1, 0), a3, ao2, 0);
            G8_WAIT_V(8); G8_WAIT_L(0); G8_BAR; G8_MMA(1, 0, At, B0); G8_MMA(1, 1, At, B1); G8_BAR; G8_SCHED;
        }
        if (wr == 0) G8_BAR;
        E(acc, cur, wr, wc, fr, fq);
        if (!has_next) break;
#pragma unroll
        for (int a = 0; a < 2; ++a)
#pragma unroll
            for (int b = 0; b < 2; ++b)
#pragma unroll
                for (int m = 0; m < 4; ++m)
#pragma unroll
                    for (int n = 0; n < 2; ++n) acc[a][b][m][n] = (f32x4){0.f, 0.f, 0.f, 0.f};
        cur = nxt; cA = nA; cB = nB; ++ui;
        if constexpr (GATHER) {
#pragma unroll
            for (int h = 0; h < 2; ++h)
#pragma unroll
                for (int i = 0; i < 2; ++i) aoc[h][i] = aon[h][i];
        }
        if (wr == 1) G8_BAR;
    }
    G8_WAIT_V(0);
    G8_BAR;
#undef G8_SA
#undef G8_SB
#undef G8_STAGE_A
#undef G8_STAGE_B
#undef G8_LDA
#undef G8_LDB
#undef G8_MMA
#undef G8_WAIT_V
#undef G8_WAIT_L
#undef G8_BAR
#undef G8_SCHED
#undef G8_AOFF
}

__device__ __forceinline__ float log_sigmoid(float x) { return fminf(x, 0.f) - __logf(1.f + __expf(-fabsf(x))); }
__device__ __forceinline__ float silu_mul(float g, float u) { return g * u * __builtin_amdgcn_rcpf(1.f + __builtin_amdgcn_exp2f(-LOG2E * g)); }

struct EpiIn {
    static constexpr bool PERM = true;
    bf16 *FQ, *FK, *FV, *KR, *CONV3, *CQ, *CKV; float* LOGF; float* SSQ; const float* bf; const f32x2* CS;
    __device__ __forceinline__ void operator()(const f32x4 (&acc)[2][2][4][2], const Unit& u, int wr, int wc, int fr, int fq) const {
        asm volatile("" : "+v"(fr), "+v"(fq));
        const int row0 = u.pm * 256 + wr * 64 + fr;
#pragma unroll
        for (int bj = 0; bj < 2; ++bj) {
            const int hb = 2 * u.pn + bj;
            if (hb == 9) {
                if (wc == 0) {
#pragma unroll
                    for (int ai = 0; ai < 2; ++ai)
#pragma unroll
                        for (int m = 0; m < 4; ++m) {
                            const int row = row0 + ai * 128 + m * 16, t = row & (SEQ - 1);
                            const f32x4 v0 = acc[ai][bj][m][0], v1 = acc[ai][bj][m][1];
                            const f32x4 c01 = *(const f32x4*)(CS + t * 16 + 4 * fq), c23 = *(const f32x4*)(CS + t * 16 + 4 * fq + 2);
                            u32x4 w;
                            w.x = pk2(v0[0] * c01[0] - v0[1] * c01[1], v0[1] * c01[0] + v0[0] * c01[1]);
                            w.y = pk2(v0[2] * c01[2] - v0[3] * c01[3], v0[3] * c01[2] + v0[2] * c01[3]);
                            w.z = pk2(v1[0] * c23[0] - v1[1] * c23[1], v1[1] * c23[0] + v1[0] * c23[1]);
                            w.w = pk2(v1[2] * c23[2] - v1[3] * c23[3], v1[3] * c23[2] + v1[2] * c23[3]);
                            *(u32x4*)(KR + (size_t)row * 32 + 8 * fq) = w;
                        }
                } else if (wc == 1) {
                    if (fq == 0) {
#pragma unroll
                        for (int ai = 0; ai < 2; ++ai)
#pragma unroll
                            for (int m = 0; m < 4; ++m) {
                                const int row = row0 + ai * 128 + m * 16;
                                const f32x4 v0 = acc[ai][bj][m][0], v1 = acc[ai][bj][m][1];
                                f32x4 o0, o1;
                                o0[0] = log_sigmoid(v0[0] + bf[0]); o0[1] = log_sigmoid(v0[1] + bf[1]); o0[2] = log_sigmoid(v0[2] + bf[2]); o0[3] = log_sigmoid(v0[3] + bf[3]);
                                o1[0] = log_sigmoid(v1[0] + bf[4]); o1[1] = log_sigmoid(v1[1] + bf[5]); o1[2] = 0.f; o1[3] = 0.f;
                                *(f32x4*)(LOGF + (size_t)row * 8) = o0; *(f32x4*)(LOGF + (size_t)row * 8 + 4) = o1;
                            }
                    }
                }
                continue;
            }
            bf16* base; int ld, colo; float sc = 1.f;
            if (hb < 3) { base = FQ; ld = 384; colo = 128 * hb; sc = C2F; }
            else if (hb < 6) { base = FK; ld = 384; colo = 128 * (hb - 3); }
            else if (hb < 9) { base = FV; ld = 384; colo = 128 * (hb - 6); }
            else if (hb < 16) { base = CONV3; ld = 768; colo = 128 * (hb - 10); }
            else if (hb < 18) { base = CQ; ld = 256; colo = 128 * (hb - 16); }
            else { base = CKV; ld = 256; colo = 128 * (hb - 18); }
            const int col = colo + wc * 32 + 8 * fq;
#pragma unroll
            for (int ai = 0; ai < 2; ++ai)
#pragma unroll
                for (int m = 0; m < 4; ++m) {
                    const int row = row0 + ai * 128 + m * 16;
                    const f32x4 v0 = acc[ai][bj][m][0] * sc, v1 = acc[ai][bj][m][1] * sc;
                    u32x4 w; w.x = pk2(v0[0], v0[1]); w.y = pk2(v0[2], v0[3]); w.z = pk2(v1[0], v1[1]); w.w = pk2(v1[2], v1[3]);
                    *(u32x4*)(base + (size_t)row * ld + col) = w;
                }
        }
        if (u.pn >= 8) {
            float* sq = SSQ + (size_t)(u.pn - 8) * T * 4;
#pragma unroll
            for (int ai = 0; ai < 2; ++ai)
#pragma unroll
                for (int m = 0; m < 4; ++m) {
                    float s = 0.f;
#pragma unroll
                    for (int bj = 0; bj < 2; ++bj)
#pragma unroll
                        for (int n = 0; n < 2; ++n) { const f32x4 x = acc[ai][bj][m][n]; s += (x[0] * x[0] + x[1] * x[1]) + (x[2] * x[2] + x[3] * x[3]); }
                    s += lane_xor(s, fq * 16 + fr, 16); s += lane_xor(s, fq * 16 + fr, 32);
                    if (fq == 0) sq[(size_t)(row0 + ai * 128 + m * 16) * 4 + wc] = s;
                }
        }
    }
};

template <int GRP> struct EpiUp {
    static constexpr bool PERM = true;
    bf16 *QM, *KVM; const float* SSQ; const f32x2* CS;
    __device__ __forceinline__ void operator()(const f32x4 (&acc)[2][2][4][2], const Unit& u, int wr, int wc, int fr, int fq) const {
        asm volatile("" : "+v"(fr), "+v"(fq));
        const int row0 = u.pm * 256 + wr * 64 + fr;
        const float* sq = SSQ + (size_t)GRP * T * 4;
#pragma unroll
        for (int ai = 0; ai < 2; ++ai)
#pragma unroll
            for (int m = 0; m < 4; ++m) {
                const int row = row0 + ai * 128 + m * 16, t = row & (SEQ - 1);
                const f32x4 p = *(const f32x4*)(sq + (size_t)row * 4);
                const float rstd = __builtin_amdgcn_rsqf(((p[0] + p[1]) + (p[2] + p[3])) * (1.f / 256.f) + RMS_EPS);
#pragma unroll
                for (int bj = 0; bj < 2; ++bj) {
                    const int col = u.pn * 256 + bj * 128 + wc * 32 + 8 * fq;
                    if (GRP == 0) {
                        if (col < 576) {
                            const float s = rstd * C2M;
                            f32x4 v0 = acc[ai][bj][m][0] * s, v1 = acc[ai][bj][m][1] * s;
                            const int j = col % 96;
                            if (j >= 64) {
                                const int pi = (j - 64) >> 1;
                                const f32x4 c01 = *(const f32x4*)(CS + t * 16 + pi), c23 = *(const f32x4*)(CS + t * 16 + pi + 2);
                                f32x4 r0, r1;
                                r0[0] = v0[0] * c01[0] - v0[1] * c01[1]; r0[1] = v0[1] * c01[0] + v0[0] * c01[1];
                                r0[2] = v0[2] * c01[2] - v0[3] * c01[3]; r0[3] = v0[3] * c01[2] + v0[2] * c01[3];
                                r1[0] = v1[0] * c23[0] - v1[1] * c23[1]; r1[1] = v1[1] * c23[0] + v1[0] * c23[1];
                                r1[2] = v1[2] * c23[2] - v1[3] * c23[3]; r1[3] = v1[3] * c23[2] + v1[2] * c23[3];
                                v0 = r0; v1 = r1;
                            }
                            u32x4 w; w.x = pk2(v0[0], v0[1]); w.y = pk2(v0[2], v0[3]); w.z = pk2(v1[0], v1[1]); w.w = pk2(v1[2], v1[3]);
                            *(u32x4*)(QM + (size_t)row * 576 + col) = w;
                        }
                    } else {
                        const f32x4 v0 = acc[ai][bj][m][0] * rstd, v1 = acc[ai][bj][m][1] * rstd;
                        u32x4 w; w.x = pk2(v0[0], v0[1]); w.y = pk2(v0[2], v0[3]); w.z = pk2(v1[0], v1[1]); w.w = pk2(v1[2], v1[3]);
                        *(u32x4*)(KVM + (size_t)row * 768 + col) = w;
                    }
                }
                asm volatile("" ::: "memory"); __builtin_amdgcn_sched_barrier(0);
            }
    }
};

struct EpiF32 {
    static constexpr bool PERM = false;
    float* Y; int ldc;
    __device__ __forceinline__ void operator()(const f32x4 (&acc)[2][2][4][2], const Unit& u, int wr, int wc, int fr, int fq) const {
        asm volatile("" : "+v"(fr), "+v"(fq));
        const int row0 = u.pm * 256 + wr * 64 + fr, col0 = u.pn * 256 + wc * 32 + 4 * fq;
#pragma unroll
        for (int ai = 0; ai < 2; ++ai)
#pragma unroll
            for (int m = 0; m < 4; ++m) { float* rp = Y + (size_t)(row0 + ai * 128 + m * 16) * ldc + col0;
#pragma unroll
                for (int bj = 0; bj < 2; ++bj)
#pragma unroll
                    for (int n = 0; n < 2; ++n) *(f32x4*)(rp + bj * 128 + n * 16) = acc[ai][bj][m][n]; }
    }
};

struct EpiSwiGLU {
    static constexpr bool PERM = true;
    bf16* ACT; int ld;
    __device__ __forceinline__ void operator()(const f32x4 (&acc)[2][2][4][2], const Unit& u, int wr, int wc, int fr, int fq) const {
        asm volatile("" : "+v"(fr), "+v"(fq));
        const int col = u.pn * 128 + wc * 32 + 8 * fq;
#pragma unroll
        for (int ai = 0; ai < 2; ++ai)
#pragma unroll
            for (int m = 0; m < 4; ++m) {
                const int rt = ai * 128 + wr * 64 + m * 16 + fr;
                if (rt < u.mvalid) {
                    const f32x4 g0 = acc[ai][0][m][0], g1 = acc[ai][0][m][1], u0 = acc[ai][1][m][0], u1 = acc[ai][1][m][1];
                    u32x4 w;
                    w.x = pk2(silu_mul(g0[0], u0[0]), silu_mul(g0[1], u0[1])); w.y = pk2(silu_mul(g0[2], u0[2]), silu_mul(g0[3], u0[3]));
                    w.z = pk2(silu_mul(g1[0], u1[0]), silu_mul(g1[1], u1[1])); w.w = pk2(silu_mul(g1[2], u1[2]), silu_mul(g1[3], u1[3]));
                    *(u32x4*)(ACT + (size_t)(u.rowbase + rt) * ld + col) = w;
                }
                asm volatile("" ::: "memory"); __builtin_amdgcn_sched_barrier(0);
            }
    }
};

struct EpiBf16Rows {
    static constexpr bool PERM = true;
    bf16* O; int ld;
    __device__ __forceinline__ void operator()(const f32x4 (&acc)[2][2][4][2], const Unit& u, int wr, int wc, int fr, int fq) const {
        asm volatile("" : "+v"(fr), "+v"(fq));
#pragma unroll
        for (int ai = 0; ai < 2; ++ai)
#pragma unroll
            for (int m = 0; m < 4; ++m) {
                const int rt = ai * 128 + wr * 64 + m * 16 + fr;
                if (rt < u.mvalid) {
#pragma unroll
                    for (int bj = 0; bj < 2; ++bj) {
                        const f32x4 v0 = acc[ai][bj][m][0], v1 = acc[ai][bj][m][1];
                        u32x4 w; w.x = pk2(v0[0], v0[1]); w.y = pk2(v0[2], v0[3]); w.z = pk2(v1[0], v1[1]); w.w = pk2(v1[2], v1[3]);
                        *(u32x4*)(O + (size_t)(u.rowbase + rt) * ld + u.pn * 256 + bj * 128 + wc * 32 + 8 * fq) = w;
                    }
                }
                asm volatile("" ::: "memory"); __builtin_amdgcn_sched_barrier(0);
            }
    }
};
}

#define XB_TMO      128
#define XB_XCNT(j)  (256  + 64 * (j))
#define XB_XSUB(j)  (1280 + 64 * (j))
#define XB_XGEN(j)  (2304 + 64 * (j))
#define XB_TOP      3328
#define XB_TOPGEN   3392
#define XCD_BAR_WORDS 3456
#define XB_SPIN_CAP (1u << 20)
__device__ __forceinline__ unsigned xb_ld(unsigned* p)              { return __hip_atomic_load(p, __ATOMIC_RELAXED, __HIP_MEMORY_SCOPE_AGENT); }
__device__ __forceinline__ unsigned xb_add(unsigned* p, unsigned v) { return __hip_atomic_fetch_add(p, v, __ATOMIC_RELAXED, __HIP_MEMORY_SCOPE_AGENT); }
__device__ __forceinline__ unsigned xb_xcc_id() { return (unsigned)__builtin_amdgcn_s_getreg((3 << 11) | 20) & 0xFu; }
#define XB_SPIN(cond, bar) do { unsigned _sp = 0; while (cond) { __builtin_amdgcn_s_sleep(1); \
    if ((++_sp & 255u) == 0u) { if (xb_ld(&(bar)[XB_TMO])) break; if (_sp > XB_SPIN_CAP) { atomicAdd(&(bar)[XB_TMO], 1u); break; } } } } while (0)
struct XcdBarrier { unsigned* bar; unsigned x; volatile LAS unsigned* st; };
__device__ __forceinline__ XcdBarrier xcd_barrier_post(unsigned* bar, volatile LAS unsigned* st) {
    XcdBarrier b; b.bar = bar; b.x = xb_xcc_id(); b.st = st;
    if (threadIdx.x == 0) (void)xb_add(&bar[XB_XCNT(b.x)], 1u);
    return b;
}
__device__ __forceinline__ void xcd_barrier_complete(unsigned* bar, unsigned x, unsigned& nloc, unsigned& nx) {
    const unsigned G = gridDim.x * gridDim.y * gridDim.z;
    unsigned sum, cnt, mine, sp = 0u;
    for (;;) {
        sum = 0u; cnt = 0u; mine = 0u;
#pragma unroll
        for (unsigned j = 0; j < 16; ++j) { const unsigned c = xb_ld(&bar[XB_XCNT(j)]); sum += c; cnt += (c > 0u) ? 1u : 0u; mine = (j == x) ? c : mine; }
        if (sum == G) break;
        __builtin_amdgcn_s_sleep(1);
        if ((++sp & 255u) == 0u) { if (xb_ld(&bar[XB_TMO])) break; if (sp > XB_SPIN_CAP) { atomicAdd(&bar[XB_TMO], 1u); break; } }
    }
    nloc = mine > 0u ? mine : 1u; nx = cnt > 0u ? cnt : 1u;
}
__device__ __forceinline__ void xcd_barrier(const XcdBarrier& b) {
    asm volatile("s_waitcnt vmcnt(0)" ::: "memory");
    __syncthreads();
    if (threadIdx.x == 0) {
        unsigned* bar = b.bar;
        __builtin_amdgcn_s_waitcnt(0);
        unsigned nloc = b.st[0], nx = b.st[1];
        if (nloc == 0u) { xcd_barrier_complete(bar, b.x, nloc, nx); b.st[0] = nloc; b.st[1] = nx; }
        const unsigned old = xb_add(&bar[XB_XSUB(b.x)], 1u);
        const unsigned gen = old / nloc;
        if (old + 1u == (gen + 1u) * nloc) {
            __builtin_amdgcn_fence(__ATOMIC_RELEASE, "agent");
            asm volatile("s_waitcnt vmcnt(0)" ::: "memory");
            const unsigned og = xb_add(&bar[XB_TOP], 1u);
            const unsigned tg = og / nx;
            if (og + 1u == (tg + 1u) * nx) xb_add(&bar[XB_TOPGEN], 1u);
            else XB_SPIN(xb_ld(&bar[XB_TOPGEN]) == tg, bar);
            __builtin_amdgcn_fence(__ATOMIC_ACQUIRE, "agent");
            xb_add(&bar[XB_XGEN(b.x)], 1u);
            asm volatile("s_waitcnt vmcnt(0)" ::: "memory");
        } else {
            XB_SPIN(xb_ld(&bar[XB_XGEN(b.x)]) == gen, bar);
            __builtin_amdgcn_fence(__ATOMIC_ACQUIRE, "agent");
            asm volatile("s_waitcnt vmcnt(0)" ::: "memory");
        }
    }
    __syncthreads();
}

struct Args { const float* in[24]; float* out; unsigned char* ws; int ph_lo, ph_hi; };
enum { I_X = 0, I_C, I_WMOD, I_BMOD, I_WIN, I_BF, I_WCONV, I_QG, I_KVG, I_WUQ, I_WUKV, I_HG, I_WO, I_LN1G, I_LN1B, I_LN2G, I_LN2B, I_FWG, I_FWU, I_FWD, I_RW, I_EWG, I_EWU, I_EWD };

struct Ctx {
    LAS unsigned char* lds; volatile LAS unsigned* MISC; volatile LAS int* TAB;
    unsigned* ctl; unsigned char* ws; const float* const* in; float* out;
    int tid, lane, wave, vcu;
};

__device__ __forceinline__ void transpose_item(const Ctx& F, const float* W, int Nsrc, int srccol, int k0, const float* kscale, bf16* dst, int dstK, int n0) {
    LAS float* s = (LAS float*)(F.lds + F.wave * 16640);
    const float mask = srccol >= 0 ? 1.f : 0.f; const int sc = srccol >= 0 ? srccol : 0;
    const float* src = W + (size_t)k0 * Nsrc + sc;
#pragma unroll 16
    for (int kk = 0; kk < 64; ++kk) s[kk * 65 + F.lane] = src[(size_t)kk * Nsrc] * mask;
    LDS_WAIT(); asm volatile("" ::: "memory");
    const int c = F.lane >> 3, nl = F.lane & 7;
    f32x4 ks0 = {1.f, 1.f, 1.f, 1.f}, ks1 = {1.f, 1.f, 1.f, 1.f};
    if (kscale) { ks0 = *(const f32x4*)(kscale + k0 + 8 * c); ks1 = *(const f32x4*)(kscale + k0 + 8 * c + 4); }
#pragma unroll
    for (int j = 0; j < 8; ++j) {
        const int n = nl + 8 * j; const LAS float* p = s + (8 * c) * 65 + n;
        u32x4 o; o.x = pk2(p[0] * ks0[0], p[65] * ks0[1]); o.y = pk2(p[130] * ks0[2], p[195] * ks0[3]); o.z = pk2(p[260] * ks1[0], p[325] * ks1[1]); o.w = pk2(p[390] * ks1[2], p[455] * ks1[3]);
        *(u32x4*)(dst + (size_t)(n0 + n) * dstK + k0 + 8 * c) = o;
    }
    LDS_WAIT(); asm volatile("" ::: "memory");
}

__device__ __forceinline__ void p0a(const Ctx& F) {
    const float* const* in = F.in;
    if ((int)blockIdx.x < 48) {
        const int l = blockIdx.x / 24, col0 = (blockIdx.x % 24) * 256;
        const float* c = in[I_C]; const float* wm = in[I_WMOD] + (size_t)l * 1024 * 6144;
        float sc[4][2];
#pragma unroll
        for (int b = 0; b < 4; ++b)
#pragma unroll
            for (int j = 0; j < 2; ++j) { const float v = c[b * 1024 + F.wave * 128 + j * 64 + F.lane]; sc[b][j] = v / (1.f + __expf(-v)); }
        f32x4 acc[4];
#pragma unroll
        for (int b = 0; b < 4; ++b) acc[b] = (f32x4){0.f, 0.f, 0.f, 0.f};
#pragma unroll
        for (int j = 0; j < 2; ++j) {
#pragma unroll 8
            for (int kk = 0; kk < 64; ++kk) {
                const f32x4 w4 = *(const f32x4*)(wm + (size_t)(F.wave * 128 + j * 64 + kk) * 6144 + col0 + 4 * F.lane);
#pragma unroll
                for (int b = 0; b < 4; ++b) { const float sv = lane_get(sc[b][j], kk); acc[b] += w4 * sv; }
            }
        }
        LAS float* red = (LAS float*)F.lds;
#pragma unroll
        for (int b = 0; b < 4; ++b) *(LAS f32x4*)(red + (F.wave * 4 + b) * 256 + 4 * F.lane) = acc[b];
        __syncthreads();
        float* MOD = (float*)(F.ws + WS_MOD);
        for (int idx = F.tid; idx < 1024; idx += 512) {
            const int b = idx >> 8, col = idx & 255; float s = in[I_BMOD][l * 6144 + col0 + col];
#pragma unroll
            for (int w = 0; w < 8; ++w) s += red[(w * 4 + b) * 256 + col];
            MOD[(size_t)(l * 4 + b) * 6144 + col0 + col] = s;
        }
        __syncthreads();
    }
    {
        const int idx = blockIdx.x * 512 + F.tid;
        if (idx < SEQ * 16) {
            const int pos = idx >> 4, i = idx & 15;
            double inv = 1.0; for (int j = 0; j < i; ++j) inv *= 0.56234132519034908039;
            const double ang = (double)pos * inv;
            const double TWO_PI_HI = 6.283185307179586232, TWO_PI_LO = 2.4492935982947064e-16;
            const double n = __builtin_rint(ang * 0.15915494309189533577);
            double r = __builtin_fma(-n, TWO_PI_HI, ang); r = __builtin_fma(-n, TWO_PI_LO, r);
            const double r2 = r * r; double sn = r, cs = 1.0, ts = r, tc = 1.0;
            for (int k = 1; k <= 14; ++k) { tc = -tc * r2 / (double)((2 * k - 1) * (2 * k)); cs += tc; ts = -ts * r2 / (double)((2 * k) * (2 * k + 1)); sn += ts; }
            ((f32x2*)(F.ws + WS_CS))[idx] = (f32x2){(float)cs, (float)sn};
        }
    }
    const int gw = F.vcu * NWAVES + F.wave, NGW = NBLK * NWAVES;
    for (int it = gw; it < 25600; it += NGW) {
        if (it < 1984) {
            const int l = it / 992; int r = it % 992;
            if (r < 640) {
                const int kb = r / 40, nb = r % 40, np = nb * 64 + F.lane; int sc;
                if (np < 1152) sc = np; else if (np < 1184) { const int i = np - 1152; sc = 2438 + (i >> 1) + 16 * (i & 1); } else if (np < 1190) sc = 1152 + (np - 1184); else if (np < 1280) sc = -1; else sc = 1158 + (np - 1280);
                transpose_item(F, in[I_WIN] + (size_t)l * 1024 * INW, INW, sc, kb * 64, nullptr, (bf16*)(F.ws + R_WIN) + (size_t)l * INP * 1024, 1024, nb * 64);
            } else if (r < 688) {
                r -= 640; const int kb = r / 12, nb = r % 12, np = nb * 64 + F.lane; int sc = -1;
                if (np < 576) { const int hh = np / 96, j = np % 96; if (j < 64) sc = hh * 96 + j; else { const int i = j - 64; sc = hh * 96 + 64 + (i >> 1) + 16 * (i & 1); } }
                transpose_item(F, in[I_WUQ] + (size_t)l * 256 * 576, 576, sc, kb * 64, in[I_QG] + l * 256, (bf16*)(F.ws + R_WUQ) + (size_t)l * 768 * 256, 256, nb * 64);
            } else if (r < 736) {
                r -= 688; const int kb = r / 12, nb = r % 12;
                transpose_item(F, in[I_WUKV] + (size_t)l * 256 * 768, 768, nb * 64 + F.lane, kb * 64, in[I_KVG] + l * 256, (bf16*)(F.ws + R_WUKV) + (size_t)l * 768 * 256, 256, nb * 64);
            } else {
                r -= 736; const int kb = r / 16, nb = r % 16;
                transpose_item(F, in[I_WO] + (size_t)l * 1024 * 1024, 1024, nb * 64 + F.lane, kb * 64, in[I_HG] + l * 1024, (bf16*)(F.ws + R_WO) + (size_t)l * 1024 * 1024, 1024, nb * 64);
            }
        } else if (it < 3392) {
            const int r = it - 1984, kb = r / 88, nb = r % 88, n0 = nb * 64, pn = n0 >> 8, j0 = n0 & 255;
            const float* W = j0 < 128 ? in[I_FWG] : in[I_FWU];
            transpose_item(F, W, DFF, pn * 128 + (j0 & 127) + F.lane, kb * 64, nullptr, (bf16*)(F.ws + R_WGU), 1024, n0);
        } else if (it < 4096) {
            const int r = it - 3392, kb = r / 16, nb = r % 16;
            transpose_item(F, in[I_FWD], 1024, nb * 64 + F.lane, kb * 64, nullptr, (bf16*)(F.ws + R_WD), DFF, nb * 64);
        } else {
            int r = it - 4096; const int e = r / 2688; r %= 2688;
            if (r < 1792) {
                const int kb = r / 112, nb = r % 112, n0 = nb * 64, pn = n0 >> 8, j0 = n0 & 255;
                const float* W = (j0 < 128 ? in[I_EWG] : in[I_EWU]) + (size_t)e * 1024 * DEXP;
                transpose_item(F, W, DEXP, pn * 128 + (j0 & 127) + F.lane, kb * 64, nullptr, (bf16*)(F.ws + WS_WEGU) + (size_t)e * 7168 * 1024, 1024, n0);
            } else {
                r -= 1792; const int kb = r / 16, nb = r % 16;
                transpose_item(F, in[I_EWD] + (size_t)e * DEXP * 1024, 1024, nb * 64 + F.lane, kb * 64, nullptr, (bf16*)(F.ws + WS_WED) + (size_t)e * 1024 * DEXP, DEXP, nb * 64);
            }
        }
    }
}

template <int MODE, bool MOE, bool WRITE_H>
__device__ __forceinline__ void row_phase(const Ctx& F, int l) {
    const float* MOD = (const float*)(F.ws + WS_MOD);
    const float* Y = (const float*)(F.ws + R_Y);
    float* RA = (float*)(F.ws + WS_RA);
    bf16* H = (bf16*)(F.ws + WS_H);
    volatile LAS int* lcnt = (volatile LAS int*)(F.lds);
    LAS int* rec = (LAS int*)(F.lds + 256);
    LAS float* recw = (LAS float*)(F.lds + 256 + 1024);
    LAS float* vec = (LAS float*)(F.lds + 4096);
    const int rowb = blockIdx.x * 64, b = rowb >> 12, lane = F.lane;
    const float* modb = MOD + (size_t)(l * 4 + b) * 6144;
    {
        const float* gate = modb + (MODE == 1 ? 2 : 5) * 1024;
        const float* lg = F.in[MODE == 1 ? I_LN1G : I_LN2G] + l * 1024; const float* lb = F.in[MODE == 1 ? I_LN1B : I_LN2B] + l * 1024;
        const float* modn = MODE == 0 ? modb : (MODE == 1 ? modb + 3 * 1024 : MOD + (size_t)((l + 1) * 4 + b) * 6144);
        for (int i = F.tid; i < 1024; i += 512) {
            if (MODE != 0) { vec[i] = gate[i]; vec[1024 + i] = lg[i]; vec[2048 + i] = lb[i]; }
            if (WRITE_H) { vec[3072 + i] = modn[1024 + i]; vec[4096 + i] = modn[i]; }
        }
        if (MODE == 1 && MOE) { if (F.tid < 16) lcnt[F.tid] = 0; }
        __syncthreads();
    }
    int start[8];
    if (MODE == 2 && MOE) { int s = 0;
#pragma unroll
        for (int e = 0; e < 8; ++e) { start[e] = s; s += (int)__hip_atomic_load(F.ctl + CW_CNT + 64 * e, RLX_AGENT); } }
    const float* res = MODE == 0 ? F.in[I_X] : (MODE == 1 ? (l == 0 ? F.in[I_X] : F.out) : RA);
    float* xo = MODE == 1 ? RA : F.out;
    for (int rr = 0; rr < 4; ++rr) {
        f32x4 v[2][4];
#pragma unroll
        for (int q = 0; q < 2; ++q) {
            const int row = rowb + F.wave * 8 + rr + 4 * q;
            if (MODE == 0) {
#pragma unroll
                for (int j = 0; j < 4; ++j) v[q][j] = *(const f32x4*)(res + (size_t)row * 1024 + 4 * lane + 256 * j);
            } else {
                f32x4 y[4];
                if (MODE == 2 && MOE) {
                    const int p0 = ((const int*)(F.ws + WS_TOKP))[row * 2], p1 = ((const int*)(F.ws + WS_TOKP))[row * 2 + 1];
                    const float w0 = ((const float*)(F.ws + WS_TOKW))[row * 2], w1 = ((const float*)(F.ws + WS_TOKW))[row * 2 + 1];
                    const bf16* YR = (const bf16*)(F.ws + WS_WEGU);
                    int s0 = 0, s1 = 0;
#pragma unroll
                    for (int e = 0; e < 8; ++e) { if ((p0 >> 14) == e) s0 = start[e]; if ((p1 >> 14) == e) s1 = start[e]; }
                    const size_t r0 = (size_t)(s0 + (p0 & 16383)), r1 = (size_t)(s1 + (p1 & 16383));
#pragma unroll
                    for (int j = 0; j < 4; ++j) { const int c = 4 * lane + 256 * j; const u32x2 a = *(const u32x2*)(YR + r0 * 1024 + c), bq = *(const u32x2*)(YR + r1 * 1024 + c);
                        y[j] = (f32x4){bflo(a.x), bfhi(a.x), bflo(a.y), bfhi(a.y)} * w0 + (f32x4){bflo(bq.x), bfhi(bq.x), bflo(bq.y), bfhi(bq.y)} * w1; }
                } else {
#pragma unroll
                    for (int j = 0; j < 4; ++j) y[j] = *(const f32x4*)(Y + (size_t)row * 1024 + 4 * lane + 256 * j);
                }
#pragma unroll
                for (int j = 0; j < 4; ++j) { const int c = 4 * lane + 256 * j; const f32x4 r4 = *(const f32x4*)(res + (size_t)row * 1024 + c), g4 = *(const LAS f32x4*)(vec + c);
                    v[q][j] = r4 * ALPHA + (g4 + 1.f) * y[j]; }
            }
        }
        if (MODE != 0) {
            float s[2], qq[2];
#pragma unroll
            for (int q = 0; q < 2; ++q) { s[q] = 0.f;
#pragma unroll
                for (int j = 0; j < 4; ++j) s[q] += (v[q][j][0] + v[q][j][1]) + (v[q][j][2] + v[q][j][3]); }
#pragma unroll
            for (int o = 1; o < 64; o <<= 1) { s[0] += lane_xor(s[0], lane, o); s[1] += lane_xor(s[1], lane, o); }
#pragma unroll
            for (int q = 0; q < 2; ++q) { const float mean = s[q] * (1.f / 1024.f); qq[q] = 0.f;
#pragma unroll
                for (int j = 0; j < 4; ++j) { v[q][j] = v[q][j] - mean; qq[q] += (v[q][j][0] * v[q][j][0] + v[q][j][1] * v[q][j][1]) + (v[q][j][2] * v[q][j][2] + v[q][j][3] * v[q][j][3]); } }
#pragma unroll
            for (int o = 1; o < 64; o <<= 1) { qq[0] += lane_xor(qq[0], lane, o); qq[1] += lane_xor(qq[1], lane, o); }
#pragma unroll
            for (int q = 0; q < 2; ++q) {
                const int row = rowb + F.wave * 8 + rr + 4 * q;
                const float rstd = __builtin_amdgcn_rsqf(qq[q] * (1.f / 1024.f) + LN_EPS);
#pragma unroll
                for (int j = 0; j < 4; ++j) { const int c = 4 * lane + 256 * j; const f32x4 g4 = *(const LAS f32x4*)(vec + 1024 + c), b4 = *(const LAS f32x4*)(vec + 2048 + c);
                    v[q][j] = v[q][j] * rstd * g4 + b4; *(f32x4*)(xo + (size_t)row * 1024 + c) = v[q][j]; }
            }
        }
        if (WRITE_H) {
#pragma unroll
            for (int q = 0; q < 2; ++q) {
                const int row = rowb + F.wave * 8 + rr + 4 * q;
#pragma unroll
                for (int j = 0; j < 4; ++j) { const int c = 4 * lane + 256 * j; const f32x4 sc = *(const LAS f32x4*)(vec + 3072 + c), sh = *(const LAS f32x4*)(vec + 4096 + c);
                    v[q][j] = v[q][j] * (sc + 1.f) + sh;
                    u32x2 w; w.x = pk2(v[q][j][0], v[q][j][1]); w.y = pk2(v[q][j][2], v[q][j][3]); *(u32x2*)(H + (size_t)row * 1024 + c) = w; }
            }
        }
        if (MODE == 1 && MOE) {
            const float* rw = F.in[I_RW];
#pragma unroll
            for (int q = 0; q < 2; ++q) {
                const int rl = F.wave * 8 + rr + 4 * q;
                float lg8[8];
#pragma unroll
                for (int e = 0; e < 8; ++e) lg8[e] = 0.f;
#pragma unroll
                for (int j = 0; j < 4; ++j)
#pragma unroll
                    for (int i = 0; i < 4; ++i) { const int c = 4 * lane + 256 * j + i; const f32x4 wa = *(const f32x4*)(rw + (size_t)c * 8), wb = *(const f32x4*)(rw + (size_t)c * 8 + 4); const float hv = v[q][j][i];
                        lg8[0] += hv * wa[0]; lg8[1] += hv * wa[1]; lg8[2] += hv * wa[2]; lg8[3] += hv * wa[3]; lg8[4] += hv * wb[0]; lg8[5] += hv * wb[1]; lg8[6] += hv * wb[2]; lg8[7] += hv * wb[3]; }
#pragma unroll
                for (int o = 1; o < 64; o <<= 1)
#pragma unroll
                    for (int e = 0; e < 8; ++e) lg8[e] += lane_xor(lg8[e], lane, o);
                int e0 = 0; float m0 = lg8[0];
#pragma unroll
                for (int e = 1; e < 8; ++e) if (lg8[e] > m0) { m0 = lg8[e]; e0 = e; }
                int e1 = -1; float m1 = -INFINITY;
#pragma unroll
                for (int e = 0; e < 8; ++e) if (e != e0 && lg8[e] > m1) { m1 = lg8[e]; e1 = e; }
                if (lane == 0) {
                    const float ex = __expf(m1 - m0), w0 = 1.f / (1.f + ex), w1 = ex / (1.f + ex);
                    const int k0 = __hip_atomic_fetch_add((LAS int*)(F.lds) + e0, 1, __ATOMIC_RELAXED, __HIP_MEMORY_SCOPE_WORKGROUP);
                    const int k1 = __hip_atomic_fetch_add((LAS int*)(F.lds) + e1, 1, __ATOMIC_RELAXED, __HIP_MEMORY_SCOPE_WORKGROUP);
                    rec[rl * 4 + 0] = e0; rec[rl * 4 + 1] = e1; rec[rl * 4 + 2] = k0; rec[rl * 4 + 3] = k1; recw[rl * 2] = w0; recw[rl * 2 + 1] = w1;
                }
            }
        }
    }
    if (MODE == 1 && MOE) {
        __syncthreads();
        if (F.tid < 8) lcnt[8 + F.tid] = (int)__hip_atomic_fetch_add(F.ctl + CW_CNT + 64 * F.tid, (unsigned)lcnt[F.tid], RLX_AGENT);
        __syncthreads();
        if (F.tid < 128) {
            const int rl = F.tid >> 1, k = F.tid & 1, e = rec[rl * 4 + k], pos = lcnt[8 + e] + rec[rl * 4 + 2 + k], row = rowb + rl;
            ((int*)(F.ws + WS_ROWL))[e * 16384 + pos] = row;
            ((int*)(F.ws + WS_TOKP))[row * 2 + k] = e * 16384 + pos;
            ((float*)(F.ws + WS_TOKW))[row * 2 + k] = recw[rl * 2 + k];
        }
    }
    __syncthreads();
}

__device__ __forceinline__ void scan_conv(const Ctx& F, int l) {
    const int gw = F.vcu * NWAVES + F.wave, lane = F.lane;
    if (gw >= 2048 - 24) {
        const int bh = gw - (2048 - 24), b = bh / 6, h = bh % 6; const float* LOGF = (const float*)(F.ws + WS_LOGF); float* G = (float*)(F.ws + WS_G) + (size_t)bh * SEQ;
        float v[64];
#pragma unroll
        for (int j = 0; j < 64; ++j) v[j] = LOGF[(size_t)(b * SEQ + j * 64 + lane) * 8 + h];
#pragma unroll
        for (int o = 1; o < 64; o <<= 1) {
#pragma unroll
            for (int j = 0; j < 64; ++j) { const float t = lane_get(v[j], lane - o); if (lane >= o) v[j] += t; }
        }
        float carry = 0.f;
#pragma unroll
        for (int j = 0; j < 64; ++j) { const float tot = __int_as_float(__builtin_amdgcn_readlane(__float_as_int(v[j]), 63)); v[j] += carry; carry += tot; G[j * 64 + lane] = -v[j] * LOG2E; }
    }
    const bf16* C3 = (const bf16*)(F.ws + R_CONV3); bf16* OM = (bf16*)(F.ws + R_OM);
    const float* wc = F.in[I_WCONV] + l * 3 * 256;
    const f32x4 w0 = *(const f32x4*)(wc + 4 * lane), w1 = *(const f32x4*)(wc + 256 + 4 * lane), w2 = *(const f32x4*)(wc + 512 + 4 * lane);
    const int m0 = gw * 8, t0 = m0 & (SEQ - 1);
    u32x2 cg[10], hn[10], bg[8];
#pragma unroll
    for (int i = 0; i < 10; ++i) { const int m = (t0 == 0 && i < 2) ? m0 : m0 - 2 + i; const bf16* rp = C3 + (size_t)m * 768 + 4 * lane; cg[i] = *(const u32x2*)(rp + 256); hn[i] = *(const u32x2*)(rp + 512); }
#pragma unroll
    for (int i = 0; i < 8; ++i) bg[i] = *(const u32x2*)(C3 + (size_t)(m0 + i) * 768 + 4 * lane);
    f32x4 u[10];
#pragma unroll
    for (int i = 0; i < 10; ++i) { u[i] = (f32x4){bflo(cg[i].x) * bflo(hn[i].x), bfhi(cg[i].x) * bfhi(hn[i].x), bflo(cg[i].y) * bflo(hn[i].y), bfhi(cg[i].y) * bfhi(hn[i].y)}; if (t0 == 0 && i < 2) u[i] = (f32x4){0.f, 0.f, 0.f, 0.f}; }
    float ss[8]; f32x4 o[8];
#pragma unroll
    for (int i = 0; i < 8; ++i) {
        const f32x4 cv = u[i] * w0 + u[i + 1] * w1 + u[i + 2] * w2;
        o[i] = cv * (f32x4){bflo(bg[i].x), bfhi(bg[i].x), bflo(bg[i].y), bfhi(bg[i].y)};
        ss[i] = (o[i][0] * o[i][0] + o[i][1] * o[i][1]) + (o[i][2] * o[i][2] + o[i][3] * o[i][3]);
    }
#pragma unroll
    for (int x = 1; x < 16; x <<= 1)
#pragma unroll
        for (int i = 0; i < 8; ++i) ss[i] += lane_xor(ss[i], lane, x);
#pragma unroll
    for (int i = 0; i < 8; ++i) {
        const float rstd = __builtin_amdgcn_rsqf(ss[i] * (1.f / 64.f) + RMS_EPS);
        const f32x4 r = o[i] * rstd; u32x2 w; w.x = pk2(r[0], r[1]); w.y = pk2(r[2], r[3]);
        *(u32x2*)(OM + (size_t)(m0 + i) * 1024 + 384 + 4 * lane) = w;
    }
}

namespace att {
typedef short v4i16_t __attribute__((ext_vector_type(4)));
constexpr int KB0 = 0, KBSZ = 12288, VB0 = 2 * KBSZ, VBSZ = 8192, GB0 = VB0 + 2 * VBSZ, WSF0 = GB0 + 512, OST0 = WSF0 + 2048;
static_assert(OST0 + 8 * 8192 <= RING_BYTES, "attention LDS");
__device__ __forceinline__ int crow(int r, int hi) { return (r & 3) + 8 * (r >> 2) + 4 * hi; }
__device__ __forceinline__ s16x4 vtr(const LAS unsigned char* p) { return __builtin_bit_cast(s16x4, __builtin_amdgcn_ds_read_tr16_b64_v4i16((LAS v4i16_t*)p)); }

template <bool FOX>
__device__ __forceinline__ void unit(const Ctx& F, int b, int h, int qb) {
    constexpr int ND = FOX ? 4 : 6;
    const int lane = F.lane, wid = F.wave, r32 = lane & 31, hi = lane >> 5;
    const size_t rowbase = (size_t)b * SEQ; const int q0 = qb * 256;
    const bf16 *Qp, *Kp, *Vp; int qpitch, kpitch;
    if (FOX) { Qp = (const bf16*)(F.ws + R_FQ) + rowbase * 384 + h * 64; Kp = (const bf16*)(F.ws + R_FK) + rowbase * 384 + h * 64; Vp = (const bf16*)(F.ws + R_FV) + rowbase * 384 + h * 64; qpitch = 384; kpitch = 384; }
    else { Qp = (const bf16*)(F.ws + R_QM) + rowbase * 576 + h * 96; Kp = (const bf16*)(F.ws + R_KVM) + rowbase * 768 + h * 128; Vp = Kp + 64; qpitch = 576; kpitch = 768; }
    const bf16* KRp = (const bf16*)(F.ws + R_KR) + rowbase * 32;
    const float* Gp = (const float*)(F.ws + WS_G) + (size_t)(b * 6 + h) * SEQ;
    LAS unsigned char* lds = F.lds;
    LAS float* wsf = (LAS float*)(lds + WSF0) + wid * 64;
    LAS float* ost = (LAS float*)(lds + OST0 + wid * 8192);
    const int NT = (q0 + 256) / 64;
    bf16x8 qr[ND];
    { const bf16* Qw = Qp + (size_t)(q0 + wid * 32 + r32) * qpitch + hi * 8;
#pragma unroll
      for (int d0 = 0; d0 < ND; ++d0) qr[d0] = *(const bf16x8*)(Qw + d0 * 16); }
    u32x4 kreg0, kreg1 = {0u, 0u, 0u, 0u}, vreg; float greg = 0.f;
    const bf16* ksrc = Kp + (size_t)lane * kpitch + wid * 8;
    const bf16* krsrc = KRp + (size_t)lane * 32 + (wid & 3) * 8;
    const bf16* vsrc = Vp + (size_t)(16 * (wid & 3) + (lane >> 2)) * kpitch + (wid >> 2) * 32 + (lane & 3) * 8;
#define ATT_LOAD(t) do { kreg0 = *(const u32x4*)(ksrc + (size_t)(t) * 64 * kpitch); if (!FOX && wid < 4) kreg1 = *(const u32x4*)(krsrc + (size_t)(t) * 64 * 32); \
        vreg = *(const u32x4*)(vsrc + (size_t)(t) * 64 * kpitch); if (FOX && wid == 0) greg = Gp[(t) * 64 + lane]; } while (0)
#define ATT_STORE(buf) do { *(LAS u32x4*)(lds + KB0 + (buf) * KBSZ + wid * 1024 + lane * 16) = kreg0; if (!FOX && wid < 4) *(LAS u32x4*)(lds + KB0 + (buf) * KBSZ + (8 + wid) * 1024 + lane * 16) = kreg1; \
        *(LAS u32x4*)(lds + VB0 + (buf) * VBSZ + wid * 1024 + lane * 16) = vreg; if (FOX && wid == 0) *(LAS float*)(lds + GB0 + (buf) * 256 + lane * 4) = greg; } while (0)
    f32x16 o[2]; o[0] = f32x16{}; o[1] = f32x16{};
    float m_run = -INFINITY, l_run = 0.f;
    const int qmin = q0 + wid * 32, qabs = qmin + r32;
    ATT_LOAD(0); ATT_STORE(0);
    __syncthreads();
    for (int t = 0; t < NT; ++t) {
        const int buf = t & 1;
        if (t + 1 < NT) ATT_LOAD(t + 1);
        if (64 * t <= qmin + 31) {
            const LAS unsigned char* kb = lds + KB0 + buf * KBSZ + hi * 1024 + r32 * 16;
            f32x16 p0 = f32x16{}, p1 = f32x16{};
#pragma unroll
            for (int d0 = 0; d0 < ND; ++d0) {
                const bf16x8 k0f = *(const LAS bf16x8*)(kb + d0 * 2048), k1f = *(const LAS bf16x8*)(kb + d0 * 2048 + 512);
                p0 = __builtin_amdgcn_mfma_f32_32x32x16_bf16(k0f, qr[d0], p0, 0, 0, 0);
                p1 = __builtin_amdgcn_mfma_f32_32x32x16_bf16(k1f, qr[d0], p1, 0, 0, 0);
            }
            if (FOX) {
                const LAS float* gb = (const LAS float*)(lds + GB0 + buf * 256);
#pragma unroll
                for (int g = 0; g < 4; ++g) { const f32x4 a = *(const LAS f32x4*)(gb + 8 * g + 4 * hi), c = *(const LAS f32x4*)(gb + 32 + 8 * g + 4 * hi);
#pragma unroll
                    for (int j = 0; j < 4; ++j) { p0[4 * g + j] += a[j]; p1[4 * g + j] += c[j]; } }
            }
            if (64 * t + 63 > qmin) {
#pragma unroll
                for (int r = 0; r < 16; ++r) { const int kv = 64 * t + crow(r, hi); if (kv > qabs) p0[r] = -INFINITY; if (kv + 32 > qabs) p1[r] = -INFINITY; }
            }
            float mx = p0[0];
#pragma unroll
            for (int r = 1; r < 16; ++r) mx = fmaxf(mx, p0[r]);
#pragma unroll
            for (int r = 0; r < 16; ++r) mx = fmaxf(mx, p1[r]);
            mx = fmaxf(mx, lane_xor(mx, lane, 32));
            const float m_new = fmaxf(m_run, mx);
            const float alpha = __builtin_amdgcn_exp2f(m_run - m_new);
            m_run = m_new;
            float ls = 0.f;
#pragma unroll
            for (int r = 0; r < 16; ++r) { p0[r] = __builtin_amdgcn_exp2f(p0[r] - m_new); p1[r] = __builtin_amdgcn_exp2f(p1[r] - m_new); ls += p0[r] + p1[r]; }
            l_run = l_run * alpha + ls;
            if (hi == 0) wsf[r32] = alpha;
            LDS_WAIT();
#pragma unroll
            for (int g = 0; g < 4; ++g) { const f32x4 a = *(const LAS f32x4*)(wsf + 8 * g + 4 * hi);
#pragma unroll
                for (int j = 0; j < 4; ++j) { o[0][4 * g + j] *= a[j]; o[1][4 * g + j] *= a[j]; } }
            u32x4 pw[4];
#pragma unroll
            for (int s = 0; s < 2; ++s) {
                pw[s] = (u32x4){pk2(p0[8 * s], p0[8 * s + 1]), pk2(p0[8 * s + 2], p0[8 * s + 3]), pk2(p0[8 * s + 4], p0[8 * s + 5]), pk2(p0[8 * s + 6], p0[8 * s + 7])};
                pw[2 + s] = (u32x4){pk2(p1[8 * s], p1[8 * s + 1]), pk2(p1[8 * s + 2], p1[8 * s + 3]), pk2(p1[8 * s + 4], p1[8 * s + 5]), pk2(p1[8 * s + 6], p1[8 * s + 7])};
            }
            const LAS unsigned char* vb = lds + VB0 + buf * VBSZ + ((lane >> 4) & 1) * 32 + (lane & 3) * 8 + (4 * hi + ((lane & 15) >> 2)) * 64;
#pragma unroll
            for (int d0 = 0; d0 < 2; ++d0)
#pragma unroll
                for (int ks = 0; ks < 4; ++ks) {
                    const s16x4 lo = vtr(vb + d0 * 4096 + ks * 1024), hh = vtr(vb + d0 * 4096 + ks * 1024 + 512);
                    const bf16x8 vf = (bf16x8){lo[0], lo[1], lo[2], lo[3], hh[0], hh[1], hh[2], hh[3]};
                    o[d0] = __builtin_amdgcn_mfma_f32_32x32x16_bf16(__builtin_bit_cast(bf16x8, pw[ks]), vf, o[d0], 0, 0, 0);
                }
        }
        if (t + 1 < NT) ATT_STORE(buf ^ 1);
        __syncthreads();
    }
#undef ATT_LOAD
#undef ATT_STORE
    float lt = l_run + lane_xor(l_run, lane, 32);
    if (hi == 0) wsf[r32] = 1.0f / lt;
    LDS_WAIT();
#pragma unroll
    for (int g = 0; g < 4; ++g) { const f32x4 a = *(const LAS f32x4*)(wsf + 8 * g + 4 * hi);
#pragma unroll
        for (int j = 0; j < 4; ++j) { ost[crow(4 * g + j, hi) * 64 + r32] = o[0][4 * g + j] * a[j]; ost[crow(4 * g + j, hi) * 64 + 32 + r32] = o[1][4 * g + j] * a[j]; } }
    LDS_WAIT();
    bf16* OM = (bf16*)(F.ws + R_OM) + (rowbase + q0 + wid * 32) * 1024 + (FOX ? h * 64 : 640 + h * 64);
#pragma unroll
    for (int i = 0; i < 4; ++i) {
        const int row = i * 8 + (lane >> 3), ch = lane & 7;
        const f32x4 a = *(const LAS f32x4*)(ost + row * 64 + ch * 8), c = *(const LAS f32x4*)(ost + row * 64 + ch * 8 + 4);
        float s = (a[0] * a[0] + a[1] * a[1]) + (a[2] * a[2] + a[3] * a[3]) + (c[0] * c[0] + c[1] * c[1]) + (c[2] * c[2] + c[3] * c[3]);
        s += lane_xor(s, lane, 1); s += lane_xor(s, lane, 2); s += lane_xor(s, lane, 4);
        const float rstd = __builtin_amdgcn_rsqf(s * (1.f / 64.f) + RMS_EPS);
        u32x4 w; w.x = pk2(a[0] * rstd, a[1] * rstd); w.y = pk2(a[2] * rstd, a[3] * rstd); w.z = pk2(c[0] * rstd, c[1] * rstd); w.w = pk2(c[2] * rstd, c[3] * rstd);
        *(u32x4*)(OM + (size_t)row * 1024 + ch * 8) = w;
    }
    LDS_WAIT();
}

__device__ __forceinline__ void phase(const Ctx& F, int l) {
    unsigned* ctr = F.ctl + CW_AQ + 64 * l;
    for (;;) {
        if (F.tid == 0) F.MISC[4] = __hip_atomic_fetch_add(ctr, 1u, RLX_AGENT);
        __syncthreads();
        const int u = (int)F.MISC[4];
        __syncthreads();
        if (u >= 768) break;
        const int qb = 15 - u / 48, rem = u % 48, type = rem / 24, bh = rem % 24, b = bh / 6, h = bh % 6;
        if (type == 0) unit<false>(F, b, h, qb); else unit<true>(F, b, h, qb);
    }
}
}

__device__ __forceinline__ void moe_tables(const Ctx& F, int nN) {
    if (F.tid == 0) { int s = 0, up = 0;
        for (int e = 0; e < 8; ++e) { const int c = (int)__hip_atomic_load(F.ctl + CW_CNT + 64 * e, RLX_AGENT), nM = (c + 255) >> 8; F.TAB[e] = c; F.TAB[8 + e] = s; F.TAB[16 + e] = up; F.TAB[25 + e] = nM; s += c; up += nM * nN; }
        F.TAB[24] = up; }
    __syncthreads();
}

__global__ void __launch_bounds__(NWAVES * 64, 2) mk_fwd(Args args) {
    extern __shared__ __attribute__((aligned(16))) unsigned char lds_raw[];
    Ctx F;
    F.lds = (LAS unsigned char*)lds_raw; F.MISC = (volatile LAS unsigned*)(F.lds + MISC_OFF); F.TAB = (volatile LAS int*)(F.lds + TAB_OFF);
    F.tid = threadIdx.x; F.lane = F.tid & 63; F.wave = __builtin_amdgcn_readfirstlane(F.tid >> 6);
    { const int bx = blockIdx.x; F.vcu = (bx % 8) * (NBLK / 8) + bx / 8; }
    F.ws = args.ws; F.ctl = (unsigned*)(args.ws + WS_CTL); F.in = args.in; F.out = args.out;
    for (int u = F.tid; u < (LDS_BYTES - SCR_BYTES) / 4; u += NWAVES * 64) ((LAS unsigned*)(F.lds + SCR_BYTES))[u] = 0u;
    __syncthreads();
    const int lo = args.ph_lo, hi = args.ph_hi;
    XcdBarrier bar; bar.bar = F.ctl + CW_BAR; bar.x = 0; bar.st = nullptr;
    if (hi - lo > 1) bar = xcd_barrier_post(F.ctl + CW_BAR, F.MISC + 8);
    const int G = NBLK, cb = (int)blockIdx.x;

    for (int ph = lo; ph < hi; ++ph) {
        { int t_ = threadIdx.x; asm volatile("" : "+v"(t_)); F.tid = t_; F.lane = t_ & 63; F.wave = __builtin_amdgcn_readfirstlane(t_ >> 6); }
        const int nrep = ((REP_MASK >> ph) & 1) ? 2 : 1;
        for (int rep = 0; rep < nrep; ++rep) {
        if (ph == 0) { if (PHM(8)) p0a(F); }
        else if (ph == 1) { if (PHM(9)) row_phase<0, false, true>(F, 0); }
        else {
            const int l = (ph - 2) >> 3, s = (ph - 2) & 7; const bool moe = (l == 1);
            if (s == 0 && PHM(0)) {
                g8::SchedPlain S{(const char*)(F.ws + WS_H), (const char*)(F.ws + R_WIN) + (size_t)l * INP * 1024 * 2, T / 256, INP / 256, 1024, G, cb};
                g8::EpiIn E{(bf16*)(F.ws + R_FQ), (bf16*)(F.ws + R_FK), (bf16*)(F.ws + R_FV), (bf16*)(F.ws + R_KR), (bf16*)(F.ws + R_CONV3), (bf16*)(F.ws + R_CQ), (bf16*)(F.ws + R_CKV),
                            (float*)(F.ws + WS_LOGF), (float*)(F.ws + WS_SSQ), F.in[I_BF] + l * 6, (const f32x2*)(F.ws + WS_CS)};
                g8::gemm_phase<g8::EpiIn, g8::SchedPlain, false>(F.lds, F.tid, 1024, S, E);
            } else if (s == 1 && PHM(1)) {
#ifndef NO_SCANCONV
                scan_conv(F, l);
#endif
                { int t_ = threadIdx.x; asm volatile("" : "+v"(t_)); F.tid = t_; F.lane = t_ & 63; }
                { g8::SchedPlain S{(const char*)(F.ws + R_CQ), (const char*)(F.ws + R_WUQ) + (size_t)l * 768 * 256 * 2, T / 256, 3, 256, G, cb};
                  g8::EpiUp<0> E{(bf16*)(F.ws + R_QM), (bf16*)(F.ws + R_KVM), (const float*)(F.ws + WS_SSQ), (const f32x2*)(F.ws + WS_CS)};
                  g8::gemm_phase<g8::EpiUp<0>, g8::SchedPlain, false>(F.lds, F.tid, 256, S, E); }
                { int t_ = threadIdx.x; asm volatile("" : "+v"(t_)); F.tid = t_; F.lane = t_ & 63; }
                { g8::SchedPlain S{(const char*)(F.ws + R_CKV), (const char*)(F.ws + R_WUKV) + (size_t)l * 768 * 256 * 2, T / 256, 3, 256, G, (cb + 128) & 255};
                  g8::EpiUp<1> E{(bf16*)(F.ws + R_QM), (bf16*)(F.ws + R_KVM), (const float*)(F.ws + WS_SSQ), (const f32x2*)(F.ws + WS_CS)};
                  g8::gemm_phase<g8::EpiUp<1>, g8::SchedPlain, false>(F.lds, F.tid, 256, S, E); }
            } else if (s == 2 && PHM(2)) {
                att::phase(F, l + 2 * rep);
            } else if (s == 3 && PHM(3)) {
                g8::SchedPlain S{(const char*)(F.ws + R_OM), (const char*)(F.ws + R_WO) + (size_t)l * 1024 * 1024 * 2, T / 256, 4, 1024, G, cb};
                g8::EpiF32 E{(float*)(F.ws + R_Y), 1024};
                g8::gemm_phase<g8::EpiF32, g8::SchedPlain, false>(F.lds, F.tid, 1024, S, E);
            } else if (s == 4 && PHM(4)) {
                if (moe) row_phase<1, true, true>(F, l); else row_phase<1, false, true>(F, l);
            } else if (s == 5) {
                if (!moe) { if (PHM(5)) {
                    g8::SchedPlain S{(const char*)(F.ws + WS_H), (const char*)(F.ws + R_WGU), T / 256, 2 * DFF / 256, 1024, G, cb};
                    g8::EpiSwiGLU E{(bf16*)(F.ws + R_ACT), DFF};
                    g8::gemm_phase<g8::EpiSwiGLU, g8::SchedPlain, false>(F.lds, F.tid, 1024, S, E); }
                } else if (PHM(10)) {
                    moe_tables(F, 2 * DEXP / 256);
                    g8::SchedMoE S{(const char*)(F.ws + WS_H), (const char*)(F.ws + WS_WEGU), (size_t)7168 * 1024 * 2, (const int*)(F.ws + WS_ROWL), F.TAB, 2 * DEXP / 256, 1024, G, cb, true};
                    g8::EpiSwiGLU E{(bf16*)(F.ws + R_ACTM), DEXP};
                    g8::gemm_phase<g8::EpiSwiGLU, g8::SchedMoE, true>(F.lds, F.tid, 1024, S, E);
                }
            } else if (s == 6) {
                if (!moe) { if (PHM(6)) {
                    g8::SchedPlain S{(const char*)(F.ws + R_ACT), (const char*)(F.ws + R_WD), T / 256, 4, DFF, G, cb};
                    g8::EpiF32 E{(float*)(F.ws + R_Y), 1024};
                    g8::gemm_phase<g8::EpiF32, g8::SchedPlain, false>(F.lds, F.tid, DFF, S, E); }
                } else if (PHM(11)) {
                    moe_tables(F, 4);
                    g8::SchedMoE S{(const char*)(F.ws + R_ACTM), (const char*)(F.ws + WS_WED), (size_t)1024 * DEXP * 2, (const int*)(F.ws + WS_ROWL), F.TAB, 4, DEXP, G, cb, false};
                    g8::EpiBf16Rows E{(bf16*)(F.ws + WS_WEGU), 1024};
                    g8::gemm_phase<g8::EpiBf16Rows, g8::SchedMoE, false>(F.lds, F.tid, DEXP, S, E);
                }
            } else if (s == 7 && PHM(7)) {
                if (moe) row_phase<2, true, false>(F, l); else row_phase<2, false, true>(F, l);
            }
        }
        if (rep + 1 < nrep) xcd_barrier(bar);
        }
        if (ph + 1 < hi) xcd_barrier(bar);
    }
}

constexpr int N_PHASES = 18;
extern "C" void kernel_launch(void* const* d_in, const int* in_sizes, int n_in, void* d_out, int out_size, void* d_ws, size_t ws_size, hipStream_t stream) {
    static int ready = 0;
    if (ready == 0) {
        if (n_in != 24 || out_size != T * DM || ws_size < WS_END) { fprintf(stderr, "kernel_launch: unexpected problem (n_in %d, out %d, ws %zu < %zu)\n", n_in, out_size, ws_size, (size_t)WS_END); ready = -1; return; }
        if (hipFuncSetAttribute((const void*)mk_fwd, hipFuncAttributeMaxDynamicSharedMemorySize, LDS_BYTES) != hipSuccess) { fprintf(stderr, "kernel_launch: hipFuncSetAttribute failed\n"); ready = -1; return; }
        int per_cu = 0;
        if (hipOccupancyMaxActiveBlocksPerMultiprocessor(&per_cu, (const void*)mk_fwd, NWAVES * 64, LDS_BYTES) != hipSuccess || per_cu < 1) fprintf(stderr, "kernel_launch: occupancy query reports %d\n", per_cu);
        (void)hipGetLastError();
        ready = 1;
    }
    if (ready < 0) return;
    (void)hipMemsetAsync((char*)d_ws + WS_CTL, 0, CTL_ZERO_BYTES, stream);
    Args a{};
    for (int i = 0; i < 24; ++i) a.in[i] = (const float*)d_in[i];
    a.out = (float*)d_out; a.ws = (unsigned char*)d_ws;
#if MK_N_LAUNCHES == 1
    a.ph_lo = 0; a.ph_hi = N_PHASES;
    hipLaunchKernelGGL(mk_fwd, dim3(NBLK), dim3(NWAVES * 64), LDS_BYTES, stream, a);
#else
    for (int p = 0; p < N_PHASES; ++p) { a.ph_lo = p; a.ph_hi = p + 1; hipLaunchKernelGGL(mk_fwd, dim3(NBLK), dim3(NWAVES * 64), LDS_BYTES, stream, a); }
#endif
}
```

```cpp
#include <hip/hip_runtime.h>
#include <cstdio>
#include <cstdint>

#ifndef MK_N_LAUNCHES
#define MK_N_LAUNCHES 1
#endif

#ifndef PH_MASK
#define PH_MASK 0xFFF
#endif
#define PHM(k) ((PH_MASK >> (k)) & 1)
#ifndef EXPERT_SLOTS
#define EXPERT_SLOTS 1
#endif
#ifndef REP_MASK
#define REP_MASK 0
#endif
#define LAS __attribute__((address_space(3)))
typedef unsigned short bf16;
typedef short bf16x8 __attribute__((ext_vector_type(8)));
typedef short s16x4 __attribute__((ext_vector_type(4)));
typedef float f32x2 __attribute__((ext_vector_type(2)));
typedef float f32x4 __attribute__((ext_vector_type(4)));
typedef float f32x16 __attribute__((ext_vector_type(16)));
typedef unsigned u32x2 __attribute__((ext_vector_type(2)));
typedef unsigned u32x4 __attribute__((ext_vector_type(4)));
typedef __bf16 bf16x2_t __attribute__((ext_vector_type(2)));

constexpr int DM = 1024, NBATCH = 4, SEQ = 4096, T = NBATCH * SEQ;
constexpr int HF = 6, HM = 6;
constexpr int INW = 2470, INP = 2560;
constexpr int DFF = 2816, NE = 8, DEXP = 3584;
constexpr int NBLK = 256, NWAVES = 8;
constexpr float LOG2E = 1.4426950408889634f;
constexpr float C2F = 0.125f * LOG2E;
constexpr float C2M = 0.10206207261596575f * LOG2E;
constexpr float ALPHA = 1.4142135623730951f;
constexpr float LN_EPS = 1e-5f, RMS_EPS = 1e-6f;

constexpr size_t MiB = 1u << 20, KiB = 1024;
constexpr size_t WS_CTL = 0, CTL_ZERO_BYTES = 1 * MiB;
constexpr size_t WS_MOD = 1 * MiB;
constexpr size_t WS_CS = WS_MOD + 1024 * KiB;
constexpr size_t WS_G = WS_CS + 512 * KiB;
constexpr size_t WS_LOGF = WS_G + 512 * KiB;
constexpr size_t WS_SSQ = WS_LOGF + 512 * KiB;
constexpr size_t WS_ROWL = WS_SSQ + 512 * KiB;
constexpr size_t WS_TOKP = WS_ROWL + 512 * KiB;
constexpr size_t WS_TOKW = WS_TOKP + 128 * KiB;
constexpr size_t WS_WEGU = 8 * MiB;
constexpr size_t WS_WED = 120 * MiB;
constexpr size_t WS_RA = 176 * MiB;
constexpr size_t WS_H = 240 * MiB;
constexpr size_t WS_R = 272 * MiB;
constexpr size_t WS_END = 498 * MiB;
constexpr size_t R_WIN = WS_R, R_WUQ = WS_R + 10 * MiB, R_WUKV = R_WUQ + 768 * KiB, R_WO = R_WUKV + 768 * KiB, R_WGU = R_WO + 4 * MiB, R_WD = R_WGU + 11 * MiB;
constexpr size_t R_Y = WS_R + 32 * MiB;
constexpr size_t R_CONV3 = WS_R + 32 * MiB, R_CQ = WS_R + 56 * MiB, R_CKV = WS_R + 64 * MiB, R_QM = WS_R + 72 * MiB, R_KVM = WS_R + 90 * MiB, R_OM = WS_R + 114 * MiB;
constexpr size_t R_FQ = WS_R + 146 * MiB, R_FK = WS_R + 158 * MiB, R_FV = WS_R + 170 * MiB, R_KR = WS_R + 182 * MiB;
constexpr size_t R_ACT = WS_R + 96 * MiB;
constexpr size_t R_ACTM = WS_R;
static_assert(R_WD + (size_t)DM * DFF * 2 <= R_Y, "weights fit");
static_assert(R_ACT + (size_t)T * DFF * 2 <= WS_END && R_ACTM + (size_t)(32768 + 256) * DEXP * 2 <= WS_END, "act fits");
constexpr int CW_BAR = 4096, CW_CNT = 8192, CW_AQ = 9216;

constexpr int RING_BYTES = 131072, SCR_BYTES = 135168  , MISC_OFF = SCR_BYTES + 320, TAB_OFF = SCR_BYTES + 1024, LDS_BYTES = 147456;
static_assert(8 * 16640 <= SCR_BYTES, "prologue scratch");

__device__ __forceinline__ unsigned pk2(float lo, float hi) { f32x2 v = {lo, hi}; bf16x2_t b = __builtin_convertvector(v, bf16x2_t); return __builtin_bit_cast(unsigned, b); }
__device__ __forceinline__ float bflo(unsigned u) { return __uint_as_float(u << 16); }
__device__ __forceinline__ float bfhi(unsigned u) { return __uint_as_float(u & 0xffff0000u); }
__device__ __forceinline__ float lane_get(float v, int src) { return __int_as_float(__builtin_amdgcn_ds_bpermute(src << 2, __float_as_int(v))); }
__device__ __forceinline__ float lane_xor(float v, int lane, int o) { return lane_get(v, lane ^ o); }
__device__ __forceinline__ float wave_sum(float v, int lane) {
#pragma unroll
    for (int o = 1; o < 64; o <<= 1) v += lane_xor(v, lane, o);
    return v;
}
#define LDS_WAIT() asm volatile("s_waitcnt lgkmcnt(0)" ::: "memory")
#define VM_WAIT() asm volatile("s_waitcnt vmcnt(0)" ::: "memory")
#define RLX_AGENT __ATOMIC_RELAXED, __HIP_MEMORY_SCOPE_AGENT

namespace g8 {
constexpr int BM = 256, BK = 64, HALF = 128, HTB = HALF * BK * 2, STAGE_BYTES = 8 * HTB, NXCD = 8, WGM = 8;
__host__ __device__ __forceinline__ int lds_byte(int r, int c) { const int st = (r >> 4) * 2 + (c >> 5), rr = r & 15, cc = c & 31, ob = rr * 64 + cc * 2; return st * 1024 + (ob ^ (((ob >> 9) & 1) << 5)); }
__host__ __device__ __forceinline__ void stage_rc(int b, int& R, int& C) { const int st = b / 1024, sb = b % 1024, swz = sb ^ (((sb >> 9) & 1) << 5); R = (st >> 1) * 16 + swz / 64; C = (st & 1) * 32 + (swz % 64) / 2; }
__host__ __device__ __forceinline__ int perm32(int rho) { const int n = rho >> 4, i = rho & 15; return 8 * (i >> 2) + 4 * n + (i & 3); }

struct Unit { int pm, pn, grp, mvalid, rowbase; const char* a; const char* b; const int* rl; };

__device__ __forceinline__ int xcd_remap(int wgid, int nwg) { const int q = nwg / NXCD, r = nwg % NXCD, xcd = wgid % NXCD, off = wgid / NXCD; return (xcd < r ? xcd * (q + 1) : r * (q + 1) + (xcd - r) * q) + off; }
__device__ __forceinline__ void grouped_pmpn(int local, int nM, int nN, int& pm, int& pn) {
    const int nig = WGM * nN, gid = local / nig, fm = gid * WGM, gsz = (nM - fm) < WGM ? (nM - fm) : WGM;
    pm = fm + ((local % nig) % gsz); pn = (local % nig) / gsz;
}
struct SchedPlain {
    const char* A; const char* Bt; int nM, nN, K, G, c;
    __device__ __forceinline__ bool next(int i, Unit& u) const {
        const int nwg = nM * nN; const long L = (long)i * G + c; if (L >= nwg) return false;
        const int wgid = xcd_remap((int)L, nwg); int pm, pn; grouped_pmpn(wgid, nM, nN, pm, pn);
        u.pm = pm; u.pn = pn; u.grp = 0; u.mvalid = 256; u.rowbase = pm * 256; u.a = A + (size_t)pm * 256 * K * 2; u.b = Bt + (size_t)pn * 256 * K * 2; u.rl = nullptr; return true;
    }
};
struct SchedPair {
    const char* A0; const char* B0; const char* A1; const char* B1; int nM, nN, K, G, c;
    __device__ __forceinline__ bool next(int i, Unit& u) const {
        const int per = nM * nN, nwg = 2 * per; const long L = (long)i * G + c; if (L >= nwg) return false;
        const int wgid = xcd_remap((int)L, nwg); const int grp = wgid / per; int pm, pn; grouped_pmpn(wgid % per, nM, nN, pm, pn);
        u.pm = pm; u.pn = pn; u.grp = grp; u.mvalid = 256; u.rowbase = pm * 256;
        u.a = (grp ? A1 : A0) + (size_t)pm * 256 * K * 2; u.b = (grp ? B1 : B0) + (size_t)pn * 256 * K * 2; u.rl = nullptr; return true;
    }
};
struct SchedMoE {
    const char* A; const char* Bt; size_t bexp; const int* rowl; volatile LAS int* tab; int nN, K, G, c; bool gather;
    __device__ __forceinline__ int tb(int i) const { return __builtin_amdgcn_readfirstlane(tab[i]); }
    __device__ __forceinline__ bool next(int i, Unit& u) const {
        const int nwg = tb(24); const long L = (long)i * G + c; if (L >= nwg) return false;
        const int wgid = xcd_remap((int)L, nwg);
        int e = 0;
#pragma unroll
        for (int j = 1; j < 8; ++j) if (wgid >= tb(16 + j)) e = j;
        const int local = wgid - tb(16 + e), nM = tb(25 + e), cnt = tb(e), start = tb(8 + e);
        int pm, pn; grouped_pmpn(local, nM, nN, pm, pn);
        u.pm = pm; u.pn = pn; u.grp = e; u.mvalid = (cnt - pm * 256) < 256 ? (cnt - pm * 256) : 256; u.rowbase = start + pm * 256;
        u.a = gather ? A : A + (size_t)(start + pm * 256) * K * 2; u.b = Bt + (size_t)e * bexp + (size_t)pn * 256 * K * 2; u.rl = rowl + e * 16384 + pm * 256; return true;
    }
};

template <class Epi, class Sched, bool GATHER>
__device__ __forceinline__ void gemm_phase(LAS unsigned char* lds, const int tid, const int K, const Sched& S, const Epi& E) {
    const int wid = __builtin_amdgcn_readfirstlane(tid >> 6), lane = tid & 63, wr = wid >> 2, wc = wid & 3, fr = lane & 15, fq = lane >> 4;
    const int nt = K / BK;
    int RA[2], CA[2]; unsigned voffB[2];
#pragma unroll
    for (int i = 0; i < 2; ++i) { int R, C; stage_rc(tid * 16 + i * 8192, R, C); const int Rb = Epi::PERM ? ((R & ~31) + perm32(R & 31)) : R; RA[i] = R; CA[i] = C; voffB[i] = (unsigned)(Rb * K + C) * 2u; }
    const size_t kstep = (size_t)(BK * 2);
    const size_t hstep = (size_t)HALF * K * 2;
    const unsigned ldsw = (unsigned)wid * 1024u;
    const int aoff = lds_byte(wr * 64 + fr, fq * 8), boff = lds_byte(wc * 32 + fr, fq * 8);
#define G8_SA(b, h) (((b) * 2 + (h)) * HTB)
#define G8_SB(b, h) ((4 + (b) * 2 + (h)) * HTB)
#define G8_STAGE_B(bufoff, gbase) do { _Pragma("unroll") for (int _i = 0; _i < 2; ++_i) \
        __builtin_amdgcn_global_load_lds((const unsigned*)((const char*)(gbase) + voffB[_i]), (LAS unsigned*)(lds + (bufoff) + ldsw + _i * 8192), 16, 0, 0); } while (0)
#define G8_STAGE_A(bufoff, gbase, AO, h) do { _Pragma("unroll") for (int _i = 0; _i < 2; ++_i) \
        __builtin_amdgcn_global_load_lds((const unsigned*)((const char*)(gbase) + AO[h][_i]), (LAS unsigned*)(lds + (bufoff) + ldsw + _i * 8192), 16, 0, 0); } while (0)
#define G8_LDA(dst, b, h) do { _Pragma("unroll") for (int m = 0; m < 4; ++m) _Pragma("unroll") for (int k = 0; k < 2; ++k) dst[m][k] = *(const LAS bf16x8*)(lds + G8_SA(b, h) + aoff + m * 2048 + k * 1024); } while (0)
#define G8_LDB(dst, b, h) do { _Pragma("unroll") for (int n = 0; n < 2; ++n) _Pragma("unroll") for (int k = 0; k < 2; ++k) dst[n][k] = *(const LAS bf16x8*)(lds + G8_SB(b, h) + boff + n * 2048 + k * 1024); } while (0)
#define G8_MMA(ai, bj, At, Bt) do { __builtin_amdgcn_s_setprio(1); _Pragma("unroll") for (int m = 0; m < 4; ++m) _Pragma("unroll") for (int n = 0; n < 2; ++n) _Pragma("unroll") for (int k = 0; k < 2; ++k) \
        acc[ai][bj][m][n] = __builtin_amdgcn_mfma_f32_16x16x32_bf16(Bt[n][k], At[m][k], acc[ai][bj][m][n], 0, 0, 0); __builtin_amdgcn_s_setprio(0); } while (0)
#define G8_WAIT_V(n) asm volatile("s_waitcnt vmcnt(" #n ")" ::: "memory")
#define G8_WAIT_L(n) asm volatile("s_waitcnt lgkmcnt(" #n ")" ::: "memory")
#define G8_BAR __builtin_amdgcn_s_barrier()
#define G8_SCHED __builtin_amdgcn_sched_barrier(0)
#define G8_AOFF(AO, U) do { _Pragma("unroll") for (int _h = 0; _h < 2; ++_h) _Pragma("unroll") for (int _i = 0; _i < 2; ++_i) { \
        if constexpr (GATHER) { const int _r = _h * HALF + RA[_i]; const int _tok = (_r < (U).mvalid) ? (U).rl[_r] : 0; AO[_h][_i] = (unsigned)_tok * (unsigned)(K * 2) + (unsigned)(CA[_i] * 2); } \
        else AO[_h][_i] = (unsigned)((_h * HALF + RA[_i]) * K + CA[_i]) * 2u; } } while (0)
    Unit cur, nxt; int ui = 0;
    if (!S.next(0, cur)) return;
    f32x4 acc[2][2][4][2];
#pragma unroll
    for (int a = 0; a < 2; ++a)
#pragma unroll
        for (int b = 0; b < 2; ++b)
#pragma unroll
            for (int m = 0; m < 4; ++m)
#pragma unroll
                for (int n = 0; n < 2; ++n) acc[a][b][m][n] = (f32x4){0.f, 0.f, 0.f, 0.f};
    bf16x8 At[4][2], B0[2][2], B1[2][2];
    unsigned aoc[2][2], aon[2][2];
    G8_AOFF(aoc, cur);
    if constexpr (GATHER) { VM_WAIT(); }
    const char* cA = cur.a; const char* cB = cur.b;
    G8_STAGE_B(G8_SB(0, 0), cB); G8_STAGE_B(G8_SB(0, 1), cB + hstep); G8_STAGE_A(G8_SA(0, 0), cA, aoc, 0); G8_STAGE_A(G8_SA(0, 1), cA, aoc, 1);
    if (wr == 1) G8_BAR;
    G8_WAIT_V(2); G8_BAR;
    G8_STAGE_B(G8_SB(1, 0), cB + kstep); G8_STAGE_A(G8_SA(1, 0), cA + kstep, aoc, 0); G8_STAGE_B(G8_SB(1, 1), cB + hstep + kstep);
    G8_WAIT_V(6); G8_BAR;
    for (;;) {
        const bool has_next = S.next(ui + 1, nxt);
        const char* nA = has_next ? nxt.a : cA; const char* nB = has_next ? nxt.b : cB;
        if constexpr (GATHER) {
            if (has_next) { G8_AOFF(aon, nxt); }
            else {
#pragma unroll
                for (int h = 0; h < 2; ++h)
#pragma unroll
                    for (int i = 0; i < 2; ++i) aon[h][i] = aoc[h][i];
            }
        }
#pragma unroll 1
        for (int t = 0; t < nt; t += 2) {
            const bool last = (t == nt - 2);
            const char* a1 = cA + (size_t)(t + 1) * kstep;
            const char* a2 = last ? nA : cA + (size_t)(t + 2) * kstep; const char* b2 = last ? nB : cB + (size_t)(t + 2) * kstep;
            const char* a3 = a2 + kstep; const char* b3 = b2 + kstep;
            unsigned ao2[2][2];
#pragma unroll
            for (int h = 0; h < 2; ++h)
#pragma unroll
                for (int i = 0; i < 2; ++i) { if constexpr (GATHER) ao2[h][i] = last ? aon[h][i] : aoc[h][i]; else ao2[h][i] = aoc[h][i]; }
            G8_LDB(B0, 0, 0); G8_LDB(B1, 0, 1); G8_SCHED; G8_LDA(At, 0, 0); G8_STAGE_A(G8_SA(1, 1), a1, aoc, 1);
            G8_WAIT_V(8); G8_WAIT_L(0); G8_BAR; G8_MMA(0, 0, At, B0); G8_MMA(0, 1, At, B1); G8_BAR; G8_SCHED;
            G8_LDA(At, 0, 1); G8_STAGE_B(G8_SB(0, 0), b2); G8_STAGE_B(G8_SB(0, 1), b2 + hstep); G8_STAGE_A(G8_SA(0, 0), a2, ao2, 0);
            G8_WAIT_V(8); G8_WAIT_L(0); G8_BAR; G8_MMA(1, 0, At, B0); G8_MMA(1, 1, At, B1); G8_BAR; G8_SCHED;
            G8_LDB(B0, 1, 0); G8_LDB(B1, 1, 1); G8_SCHED; G8_LDA(At, 1, 0); G8_STAGE_A(G8_SA(0, 1), a2, ao2, 1);
            G8_WAIT_V(8); G8_WAIT_L(0); G8_BAR; G8_MMA(0, 0, At, B0); G8_MMA(0, 1, At, B1); G8_BAR; G8_SCHED;
            G8_LDA(At, 1, 1); G8_STAGE_B(G8_SB(1, 0), b3); G8_STAGE_B(G8_SB(1, 1), b3 + hstep); G8_STAGE_A(G8_SA(1, 0), a3, ao2, 0);
            G8_WAIT_V(8); G8_WAIT_L(0); G8_BAR; G8_MMA(1, 0, At, B0); G8_MMA(1, 1, At, B1); G8_BAR; G8_SCHED;
        }
        if (wr == 0) G8_BAR;
        E(acc, cur, wr, wc, fr, fq);
        if (!has_next) break;
#pragma unroll
        for (int a = 0; a < 2; ++a)
#pragma unroll
            for (int b = 0; b < 2; ++b)
#pragma unroll
                for (int m = 0; m < 4; ++m)
#pragma unroll
                    for (int n = 0; n < 2; ++n) acc[a][b][m][n] = (f32x4){0.f, 0.f, 0.f, 0.f};
        cur = nxt; cA = nA; cB = nB; ++ui;
        if constexpr (GATHER) {
#pragma unroll
            for (int h = 0; h < 2; ++h)
#pragma unroll
                for (int i = 0; i < 2; ++i) aoc[h][i] = aon[h][i];
        }
        if (wr == 1) G8_BAR;
    }
    G8_WAIT_V(0);
    G8_BAR;
#undef G8_SA
#undef G8_SB
#undef G8_STAGE_A
#undef G8_STAGE_B
#undef G8_LDA
#undef G8_LDB
#undef G8_MMA
#undef G8_WAIT_V
#undef G8_WAIT_L
#undef G8_BAR
#undef G8_SCHED
#undef G8_AOFF
}

__device__ __forceinline__ float log_sigmoid(float x) { return fminf(x, 0.f) - __logf(1.f + __expf(-fabsf(x))); }
__device__ __forceinline__ float silu_mul(float g, float u) { return g * u * __builtin_amdgcn_rcpf(1.f + __builtin_amdgcn_exp2f(-LOG2E * g)); }

struct EpiIn {
    static constexpr bool PERM = true;
    bf16 *FQ, *FK, *FV, *KR, *CONV3, *CQ, *CKV; float* LOGF; float* SSQ; const float* bf; const f32x2* CS;
    __device__ __forceinline__ void operator()(const f32x4 (&acc)[2][2][4][2], const Unit& u, int wr, int wc, int fr, int fq) const {
        asm volatile("" : "+v"(fr), "+v"(fq));
        const int row0 = u.pm * 256 + wr * 64 + fr;
#pragma unroll
        for (int bj = 0; bj < 2; ++bj) {
            const int hb = 2 * u.pn + bj;
            if (hb == 9) {
                if (wc == 0) {
#pragma unroll
                    for (int ai = 0; ai < 2; ++ai)
#pragma unroll
                        for (int m = 0; m < 4; ++m) {
                            const int row = row0 + ai * 128 + m * 16, t = row & (SEQ - 1);
                            const f32x4 v0 = acc[ai][bj][m][0], v1 = acc[ai][bj][m][1];
                            const f32x4 c01 = *(const f32x4*)(CS + t * 16 + 4 * fq), c23 = *(const f32x4*)(CS + t * 16 + 4 * fq + 2);
                            u32x4 w;
                            w.x = pk2(v0[0] * c01[0] - v0[1] * c01[1], v0[1] * c01[0] + v0[0] * c01[1]);
                            w.y = pk2(v0[2] * c01[2] - v0[3] * c01[3], v0[3] * c01[2] + v0[2] * c01[3]);
                            w.z = pk2(v1[0] * c23[0] - v1[1] * c23[1], v1[1] * c23[0] + v1[0] * c23[1]);
                            w.w = pk2(v1[2] * c23[2] - v1[3] * c23[3], v1[3] * c23[2] + v1[2] * c23[3]);
                            *(u32x4*)(KR + (size_t)row * 32 + 8 * fq) = w;
                        }
                } else if (wc == 1) {
                    if (fq == 0) {
#pragma unroll
                        for (int ai = 0; ai < 2; ++ai)
#pragma unroll
                            for (int m = 0; m < 4; ++m) {
                                const int row = row0 + ai * 128 + m * 16;
                                const f32x4 v0 = acc[ai][bj][m][0], v1 = acc[ai][bj][m][1];
                                f32x4 o0, o1;
                                o0[0] = log_sigmoid(v0[0] + bf[0]); o0[1] = log_sigmoid(v0[1] + bf[1]); o0[2] = log_sigmoid(v0[2] + bf[2]); o0[3] = log_sigmoid(v0[3] + bf[3]);
                                o1[0] = log_sigmoid(v1[0] + bf[4]); o1[1] = log_sigmoid(v1[1] + bf[5]); o1[2] = 0.f; o1[3] = 0.f;
                                *(f32x4*)(LOGF + (size_t)row * 8) = o0; *(f32x4*)(LOGF + (size_t)row * 8 + 4) = o1;
                            }
                    }
                }
                continue;
            }
            bf16* base; int ld, colo; float sc = 1.f;
            if (hb < 3) { base = FQ; ld = 384; colo = 128 * hb; sc = C2F; }
            else if (hb < 6) { base = FK; ld = 384; colo = 128 * (hb - 3); }
            else if (hb < 9) { base = FV; ld = 384; colo = 128 * (hb - 6); }
            else if (hb < 16) { base = CONV3; ld = 768; colo = 128 * (hb - 10); }
            else if (hb < 18) { base = CQ; ld = 256; colo = 128 * (hb - 16); }
            else { base = CKV; ld = 256; colo = 128 * (hb - 18); }
            const int col = colo + wc * 32 + 8 * fq;
#pragma unroll
            for (int ai = 0; ai < 2; ++ai)
#pragma unroll
                for (int m = 0; m < 4; ++m) {
                    const int row = row0 + ai * 128 + m * 16;
                    const f32x4 v0 = acc[ai][bj][m][0] * sc, v1 = acc[ai][bj][m][1] * sc;
                    u32x4 w; w.x = pk2(v0[0], v0[1]); w.y = pk2(v0[2], v0[3]); w.z = pk2(v1[0], v1[1]); w.w = pk2(v1[2], v1[3]);
                    *(u32x4*)(base + (size_t)row * ld + col) = w;
                }
        }
        if (u.pn >= 8) {
            float* sq = SSQ + (size_t)(u.pn - 8) * T * 4;
#pragma unroll
            for (int ai = 0; ai < 2; ++ai)
#pragma unroll
                for (int m = 0; m < 4; ++m) {
                    float s = 0.f;
#pragma unroll
                    for (int bj = 0; bj < 2; ++bj)
#pragma unroll
                        for (int n = 0; n < 2; ++n) { const f32x4 x = acc[ai][bj][m][n]; s += (x[0] * x[0] + x[1] * x[1]) + (x[2] * x[2] + x[3] * x[3]); }
                    s += lane_xor(s, fq * 16 + fr, 16); s += lane_xor(s, fq * 16 + fr, 32);
                    if (fq == 0) sq[(size_t)(row0 + ai * 128 + m * 16) * 4 + wc] = s;
                }
        }
    }
};

template <int GRP> struct EpiUp {
    static constexpr bool PERM = true;
    bf16 *QM, *KVM; const float* SSQ; const f32x2* CS;
    __device__ __forceinline__ void operator()(const f32x4 (&acc)[2][2][4][2], const Unit& u, int wr, int wc, int fr, int fq) const {
        asm volatile("" : "+v"(fr), "+v"(fq));
        const int row0 = u.pm * 256 + wr * 64 + fr;
        const float* sq = SSQ + (size_t)GRP * T * 4;
#pragma unroll
        for (int ai = 0; ai < 2; ++ai)
#pragma unroll
            for (int m = 0; m < 4; ++m) {
                const int row = row0 + ai * 128 + m * 16, t = row & (SEQ - 1);
                const f32x4 p = *(const f32x4*)(sq + (size_t)row * 4);
                const float rstd = __builtin_amdgcn_rsqf(((p[0] + p[1]) + (p[2] + p[3])) * (1.f / 256.f) + RMS_EPS);
#pragma unroll
                for (int bj = 0; bj < 2; ++bj) {
                    const int col = u.pn * 256 + bj * 128 + wc * 32 + 8 * fq;
                    if (GRP == 0) {
                        if (col < 576) {
                            const float s = rstd * C2M;
                            f32x4 v0 = acc[ai][bj][m][0] * s, v1 = acc[ai][bj][m][1] * s;
                            const int j = col % 96;
                            if (j >= 64) {
                                const int pi = (j - 64) >> 1;
                                const f32x4 c01 = *(const f32x4*)(CS + t * 16 + pi), c23 = *(const f32x4*)(CS + t * 16 + pi + 2);
                                f32x4 r0, r1;
                                r0[0] = v0[0] * c01[0] - v0[1] * c01[1]; r0[1] = v0[1] * c01[0] + v0[0] * c01[1];
                                r0[2] = v0[2] * c01[2] - v0[3] * c01[3]; r0[3] = v0[3] * c01[2] + v0[2] * c01[3];
                                r1[0] = v1[0] * c23[0] - v1[1] * c23[1]; r1[1] = v1[1] * c23[0] + v1[0] * c23[1];
                                r1[2] = v1[2] * c23[2] - v1[3] * c23[3]; r1[3] = v1[3] * c23[2] + v1[2] * c23[3];
                                v0 = r0; v1 = r1;
                            }
                            u32x4 w; w.x = pk2(v0[0], v0[1]); w.y = pk2(v0[2], v0[3]); w.z = pk2(v1[0], v1[1]); w.w = pk2(v1[2], v1[3]);
                            *(u32x4*)(QM + (size_t)row * 576 + col) = w;
                        }
                    } else {
                        const f32x4 v0 = acc[ai][bj][m][0] * rstd, v1 = acc[ai][bj][m][1] * rstd;
                        u32x4 w; w.x = pk2(v0[0], v0[1]); w.y = pk2(v0[2], v0[3]); w.z = pk2(v1[0], v1[1]); w.w = pk2(v1[2], v1[3]);
                        *(u32x4*)(KVM + (size_t)row * 768 + col) = w;
                    }
                }
                asm volatile("" ::: "memory"); __builtin_amdgcn_sched_barrier(0);
            }
    }
};

struct EpiF32 {
    static constexpr bool PERM = false;
    float* Y; int ldc;
    __device__ __forceinline__ void operator()(const f32x4 (&acc)[2][2][4][2], const Unit& u, int wr, int wc, int fr, int fq) const {
        asm volatile("" : "+v"(fr), "+v"(fq));
        const int row0 = u.pm * 256 + wr * 64 + fr, col0 = u.pn * 256 + wc * 32 + 4 * fq;
#pragma unroll
        for (int ai = 0; ai < 2; ++ai)
#pragma unroll
            for (int m = 0; m < 4; ++m) { float* rp = Y + (size_t)(row0 + ai * 128 + m * 16) * ldc + col0;
#pragma unroll
                for (int bj = 0; bj < 2; ++bj)
#pragma unroll
                    for (int n = 0; n < 2; ++n) *(f32x4*)(rp + bj * 128 + n * 16) = acc[ai][bj][m][n]; }
    }
};

struct EpiSwiGLU {
    static constexpr bool PERM = true;
    bf16* ACT; int ld;
    __device__ __forceinline__ void operator()(const f32x4 (&acc)[2][2][4][2], const Unit& u, int wr, int wc, int fr, int fq) const {
        asm volatile("" : "+v"(fr), "+v"(fq));
        const int col = u.pn * 128 + wc * 32 + 8 * fq;
#pragma unroll
        for (int ai = 0; ai < 2; ++ai)
#pragma unroll
            for (int m = 0; m < 4; ++m) {
                const int rt = ai * 128 + wr * 64 + m * 16 + fr;
                if (rt < u.mvalid) {
                    const f32x4 g0 = acc[ai][0][m][0], g1 = acc[ai][0][m][1], u0 = acc[ai][1][m][0], u1 = acc[ai][1][m][1];
                    u32x4 w;
                    w.x = pk2(silu_mul(g0[0], u0[0]), silu_mul(g0[1], u0[1])); w.y = pk2(silu_mul(g0[2], u0[2]), silu_mul(g0[3], u0[3]));
                    w.z = pk2(silu_mul(g1[0], u1[0]), silu_mul(g1[1], u1[1])); w.w = pk2(silu_mul(g1[2], u1[2]), silu_mul(g1[3], u1[3]));
                    *(u32x4*)(ACT + (size_t)(u.rowbase + rt) * ld + col) = w;
                }
                asm volatile("" ::: "memory"); __builtin_amdgcn_sched_barrier(0);
            }
    }
};

struct EpiBf16Rows {
    static constexpr bool PERM = true;
    bf16* O; int ld;
    __device__ __forceinline__ void operator()(const f32x4 (&acc)[2][2][4][2], const Unit& u, int wr, int wc, int fr, int fq) const {
        asm volatile("" : "+v"(fr), "+v"(fq));
#pragma unroll
        for (int ai = 0; ai < 2; ++ai)
#pragma unroll
            for (int m = 0; m < 4; ++m) {
                const int rt = ai * 128 + wr * 64 + m * 16 + fr;
                if (rt < u.mvalid) {
#pragma unroll
                    for (int bj = 0; bj < 2; ++bj) {
                        const f32x4 v0 = acc[ai][bj][m][0], v1 = acc[ai][bj][m][1];
                        u32x4 w; w.x = pk2(v0[0], v0[1]); w.y = pk2(v0[2], v0[3]); w.z = pk2(v1[0], v1[1]); w.w = pk2(v1[2], v1[3]);
                        *(u32x4*)(O + (size_t)(u.rowbase + rt) * ld + u.pn * 256 + bj * 128 + wc * 32 + 8 * fq) = w;
                    }
                }
                asm volatile("" ::: "memory"); __builtin_amdgcn_sched_barrier(0);
            }
    }
};
}

#define XB_TMO      128
#define XB_XCNT(j)  (256  + 64 * (j))
#define XB_XSUB(j)  (1280 + 64 * (j))
#define XB_XGEN(j)  (2304 + 64 * (j))
#define XB_TOP      3328
#define XB_TOPGEN   3392
#define XCD_BAR_WORDS 3456
#define XB_SPIN_CAP (1u << 20)
__device__ __forceinline__ unsigned xb_ld(unsigned* p)              { return __hip_atomic_load(p, __ATOMIC_RELAXED, __HIP_MEMORY_SCOPE_AGENT); }
__device__ __forceinline__ unsigned xb_add(unsigned* p, unsigned v) { return __hip_atomic_fetch_add(p, v, __ATOMIC_RELAXED, __HIP_MEMORY_SCOPE_AGENT); }
__device__ __forceinline__ unsigned xb_xcc_id() { return (unsigned)__builtin_amdgcn_s_getreg((3 << 11) | 20) & 0xFu; }
#define XB_SPIN(cond, bar) do { unsigned _sp = 0; while (cond) { __builtin_amdgcn_s_sleep(1); \
    if ((++_sp & 255u) == 0u) { if (xb_ld(&(bar)[XB_TMO])) break; if (_sp > XB_SPIN_CAP) { atomicAdd(&(bar)[XB_TMO], 1u); break; } } } } while (0)
struct XcdBarrier { unsigned* bar; unsigned x; volatile LAS unsigned* st; };
__device__ __forceinline__ XcdBarrier xcd_barrier_post(unsigned* bar, volatile LAS unsigned* st) {
    XcdBarrier b; b.bar = bar; b.x = xb_xcc_id(); b.st = st;
    if (threadIdx.x == 0) (void)xb_add(&bar[XB_XCNT(b.x)], 1u);
    return b;
}
__device__ __forceinline__ void xcd_barrier_complete(unsigned* bar, unsigned x, unsigned& nloc, unsigned& nx) {
    const unsigned G = gridDim.x * gridDim.y * gridDim.z;
    unsigned sum, cnt, mine, sp = 0u;
    for (;;) {
        sum = 0u; cnt = 0u; mine = 0u;
#pragma unroll
        for (unsigned j = 0; j < 16; ++j) { const unsigned c = xb_ld(&bar[XB_XCNT(j)]); sum += c; cnt += (c > 0u) ? 1u : 0u; mine = (j == x) ? c : mine; }
        if (sum == G) break;
        __builtin_amdgcn_s_sleep(1);
        if ((++sp & 255u) == 0u) { if (xb_ld(&bar[XB_TMO])) break; if (sp > XB_SPIN_CAP) { atomicAdd(&bar[XB_TMO], 1u); break; } }
    }
    nloc = mine > 0u ? mine : 1u; nx = cnt > 0u ? cnt : 1u;
}
__device__ __forceinline__ void xcd_barrier(const XcdBarrier& b) {
    asm volatile("s_waitcnt vmcnt(0)" ::: "memory");
    __syncthreads();
    if (threadIdx.x == 0) {
        unsigned* bar = b.bar;
        __builtin_amdgcn_s_waitcnt(0);
        unsigned nloc = b.st[0], nx = b.st[1];
        if (nloc == 0u) { xcd_barrier_complete(bar, b.x, nloc, nx); b.st[0] = nloc; b.st[1] = nx; }
        const unsigned old = xb_add(&bar[XB_XSUB(b.x)], 1u);
        const unsigned gen = old / nloc;
        if (old + 1u == (gen + 1u) * nloc) {
            __builtin_amdgcn_fence(__ATOMIC_RELEASE, "agent");
            asm volatile("s_waitcnt vmcnt(0)" ::: "memory");
            const unsigned og = xb_add(&bar[XB_TOP], 1u);
            const unsigned tg = og / nx;
            if (og + 1u == (tg + 1u) * nx) xb_add(&bar[XB_TOPGEN], 1u);
            else XB_SPIN(xb_ld(&bar[XB_TOPGEN]) == tg, bar);
            __builtin_amdgcn_fence(__ATOMIC_ACQUIRE, "agent");
            xb_add(&bar[XB_XGEN(b.x)], 1u);
            asm volatile("s_waitcnt vmcnt(0)" ::: "memory");
        } else {
            XB_SPIN(xb_ld(&bar[XB_XGEN(b.x)]) == gen, bar);
            __builtin_amdgcn_fence(__ATOMIC_ACQUIRE, "agent");
            asm volatile("s_waitcnt vmcnt(0)" ::: "memory");
        }
    }
    __syncthreads();
}

struct Args { const float* in[24]; float* out; unsigned char* ws; int ph_lo, ph_hi; };
enum { I_X = 0, I_C, I_WMOD, I_BMOD, I_WIN, I_BF, I_WCONV, I_QG, I_KVG, I_WUQ, I_WUKV, I_HG, I_WO, I_LN1G, I_LN1B, I_LN2G, I_LN2B, I_FWG, I_FWU, I_FWD, I_RW, I_EWG, I_EWU, I_EWD };

struct Ctx {
    LAS unsigned char* lds; volatile LAS unsigned* MISC; volatile LAS int* TAB;
    unsigned* ctl; unsigned char* ws; const float* const* in; float* out;
    int tid, lane, wave, vcu;
};

__device__ __forceinline__ void transpose_item(const Ctx& F, const float* W, int Nsrc, int srccol, int k0, const float* kscale, bf16* dst, int dstK, int n0) {
    LAS float* s = (LAS float*)(F.lds + F.wave * 16640);
    const float mask = srccol >= 0 ? 1.f : 0.f; const int sc = srccol >= 0 ? srccol : 0;
    const float* src = W + (size_t)k0 * Nsrc + sc;
    float v[64];
#pragma unroll
    for (int kk = 0; kk < 64; ++kk) v[kk] = src[(size_t)kk * Nsrc];
#pragma unroll
    for (int kk = 0; kk < 64; ++kk) s[kk * 65 + F.lane] = v[kk] * mask;
    LDS_WAIT(); asm volatile("" ::: "memory");
    const int c = F.lane >> 3, nl = F.lane & 7;
    f32x4 ks0 = {1.f, 1.f, 1.f, 1.f}, ks1 = {1.f, 1.f, 1.f, 1.f};
    if (kscale) { ks0 = *(const f32x4*)(kscale + k0 + 8 * c); ks1 = *(const f32x4*)(kscale + k0 + 8 * c + 4); }
#pragma unroll
    for (int j = 0; j < 8; ++j) {
        const int n = nl + 8 * j; const LAS float* p = s + (8 * c) * 65 + n;
        u32x4 o; o.x = pk2(p[0] * ks0[0], p[65] * ks0[1]); o.y = pk2(p[130] * ks0[2], p[195] * ks0[3]); o.z = pk2(p[260] * ks1[0], p[325] * ks1[1]); o.w = pk2(p[390] * ks1[2], p[455] * ks1[3]);
        *(u32x4*)(dst + (size_t)(n0 + n) * dstK + k0 + 8 * c) = o;
    }
    LDS_WAIT(); asm volatile("" ::: "memory");
}

__device__ __forceinline__ void p0_item(const Ctx& F, int it) {
    const float* const* in = F.in;
        if (it < 1984) {
            const int l = it / 992; int r = it % 992;
            if (r < 640) {
                const int kb = r / 40, nb = r % 40, np = nb * 64 + F.lane; int sc;
                if (np < 1152) sc = np; else if (np < 1184) { const int i = np - 1152; sc = 2438 + (i >> 1) + 16 * (i & 1); } else if (np < 1190) sc = 1152 + (np - 1184); else if (np < 1280) sc = -1; else sc = 1158 + (np - 1280);
                transpose_item(F, in[I_WIN] + (size_t)l * 1024 * INW, INW, sc, kb * 64, nullptr, (bf16*)(F.ws + R_WIN) + (size_t)l * INP * 1024, 1024, nb * 64);
            } else if (r < 688) {
                r -= 640; const int kb = r / 12, nb = r % 12, np = nb * 64 + F.lane; int sc = -1;
                if (np < 576) { const int hh = np / 96, j = np % 96; if (j < 64) sc = hh * 96 + j; else { const int i = j - 64; sc = hh * 96 + 64 + (i >> 1) + 16 * (i & 1); } }
                transpose_item(F, in[I_WUQ] + (size_t)l * 256 * 576, 576, sc, kb * 64, in[I_QG] + l * 256, (bf16*)(F.ws + R_WUQ) + (size_t)l * 768 * 256, 256, nb * 64);
            } else if (r < 736) {
                r -= 688; const int kb = r / 12, nb = r % 12;
                transpose_item(F, in[I_WUKV] + (size_t)l * 256 * 768, 768, nb * 64 + F.lane, kb * 64, in[I_KVG] + l * 256, (bf16*)(F.ws + R_WUKV) + (size_t)l * 768 * 256, 256, nb * 64);
            } else {
                r -= 736; const int kb = r / 16, nb = r % 16;
                transpose_item(F, in[I_WO] + (size_t)l * 1024 * 1024, 1024, nb * 64 + F.lane, kb * 64, in[I_HG] + l * 1024, (bf16*)(F.ws + R_WO) + (size_t)l * 1024 * 1024, 1024, nb * 64);
            }
        } else if (it < 3392) {
            const int r = it - 1984, kb = r / 88, nb = r % 88, n0 = nb * 64, pn = n0 >> 8, j0 = n0 & 255;
            const float* W = j0 < 128 ? in[I_FWG] : in[I_FWU];
            transpose_item(F, W, DFF, pn * 128 + (j0 & 127) + F.lane, kb * 64, nullptr, (bf16*)(F.ws + R_WGU), 1024, n0);
        } else if (it < 4096) {
            const int r = it - 3392, kb = r / 16, nb = r % 16;
            transpose_item(F, in[I_FWD], 1024, nb * 64 + F.lane, kb * 64, nullptr, (bf16*)(F.ws + R_WD), DFF, nb * 64);
        } else {
            int r = it - 4096; const int e = r / 2688; r %= 2688;
            if (r < 1792) {
                const int kb = r / 112, nb = r % 112, n0 = nb * 64, pn = n0 >> 8, j0 = n0 & 255;
                const float* W = (j0 < 128 ? in[I_EWG] : in[I_EWU]) + (size_t)e * 1024 * DEXP;
                transpose_item(F, W, DEXP, pn * 128 + (j0 & 127) + F.lane, kb * 64, nullptr, (bf16*)(F.ws + WS_WEGU) + (size_t)e * 7168 * 1024, 1024, n0);
            } else {
                r -= 1792; const int kb = r / 16, nb = r % 16;
                transpose_item(F, in[I_EWD] + (size_t)e * DEXP * 1024, 1024, nb * 64 + F.lane, kb * 64, nullptr, (bf16*)(F.ws + WS_WED) + (size_t)e * 1024 * DEXP, DEXP, nb * 64);
            }
        }
}

__device__ __forceinline__ void p0a(const Ctx& F) {
    const float* const* in = F.in;
    if ((int)blockIdx.x < 192) {
        const int kq = blockIdx.x / 48, l = (blockIdx.x % 48) / 24, col0 = (blockIdx.x % 24) * 256;
        const float* c = in[I_C]; const float* wm = in[I_WMOD] + (size_t)l * 1024 * 6144;
        const int kb = kq * 256 + F.wave * 32;
        float sc[4];
#pragma unroll
        for (int b = 0; b < 4; ++b) { const float v = c[b * 1024 + kb + (F.lane & 31)]; sc[b] = v / (1.f + __expf(-v)); }
        f32x4 acc[4];
#pragma unroll
        for (int b = 0; b < 4; ++b) acc[b] = (f32x4){0.f, 0.f, 0.f, 0.f};
        f32x4 w4[32];
#pragma unroll
        for (int kk = 0; kk < 32; ++kk) w4[kk] = *(const f32x4*)(wm + (size_t)(kb + kk) * 6144 + col0 + 4 * F.lane);
#pragma unroll
        for (int kk = 0; kk < 32; ++kk)
#pragma unroll
            for (int b = 0; b < 4; ++b) { const float sv = lane_get(sc[b], kk); acc[b] += w4[kk] * sv; }
        LAS float* red = (LAS float*)F.lds;
#pragma unroll
        for (int b = 0; b < 4; ++b) *(LAS f32x4*)(red + (F.wave * 4 + b) * 256 + 4 * F.lane) = acc[b];
        __syncthreads();
        float* MODP = (float*)(F.ws + WS_MOD) + (size_t)kq * 2 * 4 * 6144;
        for (int idx = F.tid; idx < 1024; idx += 512) {
            const int b = idx >> 8, col = idx & 255; float s = kq == 0 ? in[I_BMOD][l * 6144 + col0 + col] : 0.f;
#pragma unroll
            for (int w = 0; w < 8; ++w) s += red[(w * 4 + b) * 256 + col];
            MODP[(size_t)(l * 4 + b) * 6144 + col0 + col] = s;
        }
        __syncthreads();
    }
    {
        const int idx = blockIdx.x * 512 + F.tid;
        if (idx < SEQ * 16) {
            const int pos = idx >> 4, i = idx & 15;
            double inv = 1.0; for (int j = 0; j < i; ++j) inv *= 0.56234132519034908039;
            const double ang = (double)pos * inv;
            const double TWO_PI_HI = 6.283185307179586232, TWO_PI_LO = 2.4492935982947064e-16;
            const double n = __builtin_rint(ang * 0.15915494309189533577);
            double r = __builtin_fma(-n, TWO_PI_HI, ang); r = __builtin_fma(-n, TWO_PI_LO, r);
            const double r2 = r * r; double sn = r, cs = 1.0, ts = r, tc = 1.0;
            for (int k = 1; k <= 14; ++k) { tc = -tc * r2 / (double)((2 * k - 1) * (2 * k)); cs += tc; ts = -ts * r2 / (double)((2 * k) * (2 * k + 1)); sn += ts; }
            ((f32x2*)(F.ws + WS_CS))[idx] = (f32x2){(float)cs, (float)sn};
        }
    }
    const int gw = F.vcu * NWAVES + F.wave, NGW = NBLK * NWAVES;
    for (int it = gw; it < (EXPERT_SLOTS ? 4096 : 25600); it += NGW) p0_item(F, it);
}

__device__ __forceinline__ void convert_experts(const Ctx& F, int slot) {
    if (!EXPERT_SLOTS || (int)blockIdx.x < 128) return;
    const int lw = ((int)blockIdx.x - 128) * NWAVES + F.wave;
    for (int i = 0; i < 7; ++i) p0_item(F, 4096 + slot * 7168 + lw + 1024 * i);
}

template <int MODE, bool MOE, bool WRITE_H>
__device__ __forceinline__ void row_phase(const Ctx& F, int l) {
    const float* MOD = (const float*)(F.ws + WS_MOD);
    const float* Y = (const float*)(F.ws + R_Y);
    float* RA = (float*)(F.ws + WS_RA);
    bf16* H = (bf16*)(F.ws + WS_H);
    volatile LAS int* lcnt = (volatile LAS int*)(F.lds);
    LAS int* rec = (LAS int*)(F.lds + 256);
    LAS float* recw = (LAS float*)(F.lds + 256 + 1024);
    LAS float* vec = (LAS float*)(F.lds + 4096);
    const int rowb = blockIdx.x * 64, b = rowb >> 12, lane = F.lane;
    const float* modb = MOD + (size_t)(l * 4 + b) * 6144;
    {
        const float* gate = modb + (MODE == 1 ? 2 : 5) * 1024;
        const float* lg = F.in[MODE == 1 ? I_LN1G : I_LN2G] + l * 1024; const float* lb = F.in[MODE == 1 ? I_LN1B : I_LN2B] + l * 1024;
        const float* modn = MODE == 0 ? modb : (MODE == 1 ? modb + 3 * 1024 : MOD + (size_t)((l + 1) * 4 + b) * 6144);
        constexpr size_t PQ = (size_t)2 * 4 * 6144;
        for (int i = F.tid; i < 1024; i += 512) {
            if (MODE != 0) { vec[i] = (gate[i] + gate[PQ + i]) + (gate[2 * PQ + i] + gate[3 * PQ + i]); vec[1024 + i] = lg[i]; vec[2048 + i] = lb[i]; }
            if (WRITE_H) { vec[3072 + i] = (modn[1024 + i] + modn[PQ + 1024 + i]) + (modn[2 * PQ + 1024 + i] + modn[3 * PQ + 1024 + i]); vec[4096 + i] = (modn[i] + modn[PQ + i]) + (modn[2 * PQ + i] + modn[3 * PQ + i]); }
        }
        if (MODE == 1 && MOE) { if (F.tid < 16) lcnt[F.tid] = 0; }
        __syncthreads();
    }
    int start[8];
    if (MODE == 2 && MOE) { int s = 0;
#pragma unroll
        for (int e = 0; e < 8; ++e) { start[e] = s; s += (int)__hip_atomic_load(F.ctl + CW_CNT + 64 * e, RLX_AGENT); } }
    const float* res = MODE == 0 ? F.in[I_X] : (MODE == 1 ? (l == 0 ? F.in[I_X] : F.out) : RA);
    float* xo = MODE == 1 ? RA : F.out;
    for (int rr = 0; rr < 4; ++rr) {
        f32x4 v[2][4];
#pragma unroll
        for (int q = 0; q < 2; ++q) {
            const int row = rowb + F.wave * 8 + rr + 4 * q;
            if (MODE == 0) {
#pragma unroll
                for (int j = 0; j < 4; ++j) v[q][j] = *(const f32x4*)(res + (size_t)row * 1024 + 4 * lane + 256 * j);
            } else {
                f32x4 y[4];
                if (MODE == 2 && MOE) {
                    const int p0 = ((const int*)(F.ws + WS_TOKP))[row * 2], p1 = ((const int*)(F.ws + WS_TOKP))[row * 2 + 1];
                    const float w0 = ((const float*)(F.ws + WS_TOKW))[row * 2], w1 = ((const float*)(F.ws + WS_TOKW))[row * 2 + 1];
                    const bf16* YR = (const bf16*)(F.ws + WS_WEGU);
                    int s0 = 0, s1 = 0;
#pragma unroll
                    for (int e = 0; e < 8; ++e) { if ((p0 >> 14) == e) s0 = start[e]; if ((p1 >> 14) == e) s1 = start[e]; }
                    const size_t r0 = (size_t)(s0 + (p0 & 16383)), r1 = (size_t)(s1 + (p1 & 16383));
#pragma unroll
                    for (int j = 0; j < 4; ++j) { const int c = 4 * lane + 256 * j; const u32x2 a = *(const u32x2*)(YR + r0 * 1024 + c), bq = *(const u32x2*)(YR + r1 * 1024 + c);
                        y[j] = (f32x4){bflo(a.x), bfhi(a.x), bflo(a.y), bfhi(a.y)} * w0 + (f32x4){bflo(bq.x), bfhi(bq.x), bflo(bq.y), bfhi(bq.y)} * w1; }
                } else {
#pragma unroll
                    for (int j = 0; j < 4; ++j) y[j] = *(const f32x4*)(Y + (size_t)row * 1024 + 4 * lane + 256 * j);
                }
#pragma unroll
                for (int j = 0; j < 4; ++j) { const int c = 4 * lane + 256 * j; const f32x4 r4 = *(const f32x4*)(res + (size_t)row * 1024 + c), g4 = *(const LAS f32x4*)(vec + c);
                    v[q][j] = r4 * ALPHA + (g4 + 1.f) * y[j]; }
            }
        }
        if (MODE != 0) {
            float s[2], qq[2];
#pragma unroll
            for (int q = 0; q < 2; ++q) { s[q] = 0.f;
#pragma unroll
                for (int j = 0; j < 4; ++j) s[q] += (v[q][j][0] + v[q][j][1]) + (v[q][j][2] + v[q][j][3]); }
#pragma unroll
            for (int o = 1; o < 64; o <<= 1) { s[0] += lane_xor(s[0], lane, o); s[1] += lane_xor(s[1], lane, o); }
#pragma unroll
            for (int q = 0; q < 2; ++q) { const float mean = s[q] * (1.f / 1024.f); qq[q] = 0.f;
#pragma unroll
                for (int j = 0; j < 4; ++j) { v[q][j] = v[q][j] - mean; qq[q] += (v[q][j][0] * v[q][j][0] + v[q][j][1] * v[q][j][1]) + (v[q][j][2] * v[q][j][2] + v[q][j][3] * v[q][j][3]); } }
#pragma unroll
            for (int o = 1; o < 64; o <<= 1) { qq[0] += lane_xor(qq[0], lane, o); qq[1] += lane_xor(qq[1], lane, o); }
#pragma unroll
            for (int q = 0; q < 2; ++q) {
                const int row = rowb + F.wave * 8 + rr + 4 * q;
                const float rstd = __builtin_amdgcn_rsqf(qq[q] * (1.f / 1024.f) + LN_EPS);
#pragma unroll
                for (int j = 0; j < 4; ++j) { const int c = 4 * lane + 256 * j; const f32x4 g4 = *(const LAS f32x4*)(vec + 1024 + c), b4 = *(const LAS f32x4*)(vec + 2048 + c);
                    v[q][j] = v[q][j] * rstd * g4 + b4; *(f32x4*)(xo + (size_t)row * 1024 + c) = v[q][j]; }
            }
        }
        if (WRITE_H) {
#pragma unroll
            for (int q = 0; q < 2; ++q) {
                const int row = rowb + F.wave * 8 + rr + 4 * q;
#pragma unroll
                for (int j = 0; j < 4; ++j) { const int c = 4 * lane + 256 * j; const f32x4 sc = *(const LAS f32x4*)(vec + 3072 + c), sh = *(const LAS f32x4*)(vec + 4096 + c);
                    v[q][j] = v[q][j] * (sc + 1.f) + sh;
                    u32x2 w; w.x = pk2(v[q][j][0], v[q][j][1]); w.y = pk2(v[q][j][2], v[q][j][3]); *(u32x2*)(H + (size_t)row * 1024 + c) = w; }
            }
        }
        if (MODE == 1 && MOE) {
            const float* rw = F.in[I_RW];
#pragma unroll
            for (int q = 0; q < 2; ++q) {
                const int rl = F.wave * 8 + rr + 4 * q;
                float lg8[8];
#pragma unroll
                for (int e = 0; e < 8; ++e) lg8[e] = 0.f;
#pragma unroll
                for (int j = 0; j < 4; ++j)
#pragma unroll
                    for (int i = 0; i < 4; ++i) { const int c = 4 * lane + 256 * j + i; const f32x4 wa = *(const f32x4*)(rw + (size_t)c * 8), wb = *(const f32x4*)(rw + (size_t)c * 8 + 4); const float hv = v[q][j][i];
                        lg8[0] += hv * wa[0]; lg8[1] += hv * wa[1]; lg8[2] += hv * wa[2]; lg8[3] += hv * wa[3]; lg8[4] += hv * wb[0]; lg8[5] += hv * wb[1]; lg8[6] += hv * wb[2]; lg8[7] += hv * wb[3]; }
#pragma unroll
                for (int o = 1; o < 64; o <<= 1)
#pragma unroll
                    for (int e = 0; e < 8; ++e) lg8[e] += lane_xor(lg8[e], lane, o);
                int e0 = 0; float m0 = lg8[0];
#pragma unroll
                for (int e = 1; e < 8; ++e) if (lg8[e] > m0) { m0 = lg8[e]; e0 = e; }
                int e1 = -1; float m1 = -INFINITY;
#pragma unroll
                for (int e = 0; e < 8; ++e) if (e != e0 && lg8[e] > m1) { m1 = lg8[e]; e1 = e; }
                if (lane == 0) {
                    const float ex = __expf(m1 - m0), w0 = 1.f / (1.f + ex), w1 = ex / (1.f + ex);
                    const int k0 = __hip_atomic_fetch_add((LAS int*)(F.lds) + e0, 1, __ATOMIC_RELAXED, __HIP_MEMORY_SCOPE_WORKGROUP);
                    const int k1 = __hip_atomic_fetch_add((LAS int*)(F.lds) + e1, 1, __ATOMIC_RELAXED, __HIP_MEMORY_SCOPE_WORKGROUP);
                    rec[rl * 4 + 0] = e0; rec[rl * 4 + 1] = e1; rec[rl * 4 + 2] = k0; rec[rl * 4 + 3] = k1; recw[rl * 2] = w0; recw[rl * 2 + 1] = w1;
                }
            }
        }
    }
    if (MODE == 1 && MOE) {
        __syncthreads();
        if (F.tid < 8) lcnt[8 + F.tid] = (int)__hip_atomic_fetch_add(F.ctl + CW_CNT + 64 * F.tid, (unsigned)lcnt[F.tid], RLX_AGENT);
        __syncthreads();
        if (F.tid < 128) {
            const int rl = F.tid >> 1, k = F.tid & 1, e = rec[rl * 4 + k], pos = lcnt[8 + e] + rec[rl * 4 + 2 + k], row = rowb + rl;
            ((int*)(F.ws + WS_ROWL))[e * 16384 + pos] = row;
            ((int*)(F.ws + WS_TOKP))[row * 2 + k] = e * 16384 + pos;
            ((float*)(F.ws + WS_TOKW))[row * 2 + k] = recw[rl * 2 + k];
        }
    }
    __syncthreads();
}

__device__ __forceinline__ void scan_conv(const Ctx& F, int l) {
    const int gw = F.vcu * NWAVES + F.wave, lane = F.lane;
    if (gw >= 2048 - 24) {
        const int bh = gw - (2048 - 24), b = bh / 6, h = bh % 6; const float* LOGF = (const float*)(F.ws + WS_LOGF); float* G = (float*)(F.ws + WS_G) + (size_t)bh * SEQ;
        float v[64];
#pragma unroll
        for (int j = 0; j < 64; ++j) v[j] = LOGF[(size_t)(b * SEQ + j * 64 + lane) * 8 + h];
#pragma unroll
        for (int o = 1; o < 64; o <<= 1) {
#pragma unroll
            for (int j = 0; j < 64; ++j) { const float t = lane_get(v[j], lane - o); if (lane >= o) v[j] += t; }
        }
        float carry = 0.f;
#pragma unroll
        for (int j = 0; j < 64; ++j) { const float tot = __int_as_float(__builtin_amdgcn_readlane(__float_as_int(v[j]), 63)); v[j] += carry; carry += tot; G[j * 64 + lane] = -v[j] * LOG2E; }
    }
    const bf16* C3 = (const bf16*)(F.ws + R_CONV3); bf16* OM = (bf16*)(F.ws + R_OM);
    const float* wc = F.in[I_WCONV] + l * 3 * 256;
    const f32x4 w0 = *(const f32x4*)(wc + 4 * lane), w1 = *(const f32x4*)(wc + 256 + 4 * lane), w2 = *(const f32x4*)(wc + 512 + 4 * lane);
    const int m0 = gw * 8, t0 = m0 & (SEQ - 1);
    u32x2 cg[10], hn[10], bg[8];
#pragma unroll
    for (int i = 0; i < 10; ++i) { const int m = (t0 == 0 && i < 2) ? m0 : m0 - 2 + i; const bf16* rp = C3 + (size_t)m * 768 + 4 * lane; cg[i] = *(const u32x2*)(rp + 256); hn[i] = *(const u32x2*)(rp + 512); }
#pragma unroll
    for (int i = 0; i < 8; ++i) bg[i] = *(const u32x2*)(C3 + (size_t)(m0 + i) * 768 + 4 * lane);
    f32x4 u[10];
#pragma unroll
    for (int i = 0; i < 10; ++i) { u[i] = (f32x4){bflo(cg[i].x) * bflo(hn[i].x), bfhi(cg[i].x) * bfhi(hn[i].x), bflo(cg[i].y) * bflo(hn[i].y), bfhi(cg[i].y) * bfhi(hn[i].y)}; if (t0 == 0 && i < 2) u[i] = (f32x4){0.f, 0.f, 0.f, 0.f}; }
    float ss[8]; f32x4 o[8];
#pragma unroll
    for (int i = 0; i < 8; ++i) {
        const f32x4 cv = u[i] * w0 + u[i + 1] * w1 + u[i + 2] * w2;
        o[i] = cv * (f32x4){bflo(bg[i].x), bfhi(bg[i].x), bflo(bg[i].y), bfhi(bg[i].y)};
        ss[i] = (o[i][0] * o[i][0] + o[i][1] * o[i][1]) + (o[i][2] * o[i][2] + o[i][3] * o[i][3]);
    }
#pragma unroll
    for (int x = 1; x < 16; x <<= 1)
#pragma unroll
        for (int i = 0; i < 8; ++i) ss[i] += lane_xor(ss[i], lane, x);
#pragma unroll
    for (int i = 0; i < 8; ++i) {
        const float rstd = __builtin_amdgcn_rsqf(ss[i] * (1.f / 64.f) + RMS_EPS);
        const f32x4 r = o[i] * rstd; u32x2 w; w.x = pk2(r[0], r[1]); w.y = pk2(r[2], r[3]);
        *(u32x2*)(OM + (size_t)(m0 + i) * 1024 + 384 + 4 * lane) = w;
    }
}

namespace att {
typedef short v4i16_t __attribute__((ext_vector_type(4)));
constexpr int KB0 = 0, KBSZ = 12288, VB0 = 2 * KBSZ, VBSZ = 8192, GB0 = VB0 + 2 * VBSZ;
static_assert(GB0 + 512 <= RING_BYTES, "attention LDS");
__device__ __forceinline__ int crow(int r, int hi) { return (r & 3) + 8 * (r >> 2) + 4 * hi; }
__device__ __forceinline__ s16x4 vtr(const LAS unsigned char* p) { return __builtin_bit_cast(s16x4, __builtin_amdgcn_ds_read_tr16_b64_v4i16((LAS v4i16_t*)p)); }

__device__ __forceinline__ float half_max(float x) { auto rr = __builtin_amdgcn_permlane32_swap(__float_as_uint(x), __float_as_uint(x), false, false); return fmaxf(__uint_as_float(rr[0]), __uint_as_float(rr[1])); }
__device__ __forceinline__ float half_sum(float x) { auto rr = __builtin_amdgcn_permlane32_swap(__float_as_uint(x), __float_as_uint(x), false, false); return __uint_as_float(rr[0]) + __uint_as_float(rr[1]); }

template <bool FOX>
__device__ __forceinline__ void unit(const Ctx& F, int b, int h, int qb) {
    constexpr int ND = FOX ? 4 : 6;
    const int lane = F.lane, wid = F.wave, r32 = lane & 31, hi = lane >> 5;
    const size_t rowbase = (size_t)b * SEQ; const int q0 = qb * 256;
    const bf16 *Qp, *Kp, *Vp; int qpitch, kpitch;
    if (FOX) { Qp = (const bf16*)(F.ws + R_FQ) + rowbase * 384 + h * 64; Kp = (const bf16*)(F.ws + R_FK) + rowbase * 384 + h * 64; Vp = (const bf16*)(F.ws + R_FV) + rowbase * 384 + h * 64; qpitch = 384; kpitch = 384; }
    else { Qp = (const bf16*)(F.ws + R_QM) + rowbase * 576 + h * 96; Kp = (const bf16*)(F.ws + R_KVM) + rowbase * 768 + h * 128; Vp = Kp + 64; qpitch = 576; kpitch = 768; }
    const bf16* KRp = (const bf16*)(F.ws + R_KR) + rowbase * 32;
    const float* Gp = (const float*)(F.ws + WS_G) + (size_t)(b * 6 + h) * SEQ;
    LAS unsigned char* lds = F.lds;
    const int NT = (q0 + 256) / 64;
    bf16x8 qr[ND];
    { const bf16* Qw = Qp + (size_t)(q0 + wid * 32 + r32) * qpitch + hi * 8;
#pragma unroll
      for (int d0 = 0; d0 < ND; ++d0) qr[d0] = *(const bf16x8*)(Qw + d0 * 16); }
    u32x4 kreg0, kreg1 = {0u, 0u, 0u, 0u}, vreg; float greg = 0.f;
    const bf16* ksrc = Kp + (size_t)lane * kpitch + wid * 8;
    const bf16* krsrc = KRp + (size_t)lane * 32 + (wid & 3) * 8;
    const bf16* vsrc = Vp + (size_t)(16 * (wid & 3) + (lane >> 2)) * kpitch + (wid >> 2) * 32 + (lane & 3) * 8;
#define ATT_LOADK(t) do { kreg0 = *(const u32x4*)(ksrc + (size_t)(t) * 64 * kpitch); if (!FOX && wid < 4) kreg1 = *(const u32x4*)(krsrc + (size_t)(t) * 64 * 32); if (FOX && wid == 0) greg = Gp[(t) * 64 + lane]; } while (0)
#define ATT_LOADV(t) do { vreg = *(const u32x4*)(vsrc + (size_t)(t) * 64 * kpitch); } while (0)
#define ATT_STOREK(buf) do { *(LAS u32x4*)(lds + KB0 + (buf) * KBSZ + wid * 1024 + lane * 16) = kreg0; if (!FOX && wid < 4) *(LAS u32x4*)(lds + KB0 + (buf) * KBSZ + (8 + wid) * 1024 + lane * 16) = kreg1; \
        if (FOX && wid == 0) *(LAS float*)(lds + GB0 + (buf) * 256 + lane * 4) = greg; } while (0)
#define ATT_STOREV(buf) do { *(LAS u32x4*)(lds + VB0 + (buf) * VBSZ + wid * 1024 + lane * 16) = vreg; } while (0)
#define ATT_QK(a0, a1, buf) do { \
        if (FOX) { const LAS float* gb_ = (const LAS float*)(lds + GB0 + (buf) * 256); \
            _Pragma("unroll") for (int g_ = 0; g_ < 4; ++g_) { const f32x4 x_ = *(const LAS f32x4*)(gb_ + 8 * g_ + 4 * hi), y_ = *(const LAS f32x4*)(gb_ + 32 + 8 * g_ + 4 * hi); \
                _Pragma("unroll") for (int j_ = 0; j_ < 4; ++j_) { a0[4 * g_ + j_] = x_[j_]; a1[4 * g_ + j_] = y_[j_]; } } } \
        else { a0 = f32x16{}; a1 = f32x16{}; } \
        const LAS unsigned char* kb_ = lds + KB0 + (buf) * KBSZ + hi * 1024 + r32 * 16; \
        bf16x8 kf_[2 * ND]; \
        _Pragma("unroll") for (int d0 = 0; d0 < ND; ++d0) { kf_[2 * d0] = *(const LAS bf16x8*)(kb_ + d0 * 2048); kf_[2 * d0 + 1] = *(const LAS bf16x8*)(kb_ + d0 * 2048 + 512); } \
        __builtin_amdgcn_sched_barrier(0);        \
        _Pragma("unroll") for (int d0 = 0; d0 < ND; ++d0) { \
            a0 = __builtin_amdgcn_mfma_f32_32x32x16_bf16(kf_[2 * d0], qr[d0], a0, 0, 0, 0); a1 = __builtin_amdgcn_mfma_f32_32x32x16_bf16(kf_[2 * d0 + 1], qr[d0], a1, 0, 0, 0); } \
        __builtin_amdgcn_sched_barrier(0); } while (0)
    f32x16 o[2]; o[0] = f32x16{}; o[1] = f32x16{};
    float m_run = -INFINITY, l_run = 0.f;
    const int qmin = q0 + wid * 32, qabs = qmin + r32;
    ATT_LOADK(0); ATT_LOADV(0); ATT_STOREK(0); ATT_STOREV(0);
    ATT_LOADK(1); ATT_STOREK(1);
    __syncthreads();
    f32x16 p0, p1, n0 = f32x16{}, n1 = f32x16{};
    ATT_QK(p0, p1, 0);
    for (int t = 0; t < NT; ++t) {
        const int buf = t & 1;
        const bool act = (64 * t <= qmin + 31), actn = (t + 1 < NT) && (64 * (t + 1) <= qmin + 31);
        if (t + 2 < NT) ATT_LOADK(t + 2);
        if (t + 1 < NT) ATT_LOADV(t + 1);
        if (actn) ATT_QK(n0, n1, buf ^ 1);
        if (act) {
            if (64 * t + 63 > qmin) {
#pragma unroll
                for (int r = 0; r < 16; ++r) { const int kv = 64 * t + crow(r, hi); if (kv > qabs) p0[r] = -INFINITY; if (kv + 32 > qabs) p1[r] = -INFINITY; }
            }
            float mx = fmaxf(p0[0], p1[0]);
#pragma unroll
            for (int r = 1; r < 16; ++r) mx = fmaxf(fmaxf(mx, p0[r]), p1[r]);
            mx = half_max(mx);
            const float m_new = fmaxf(m_run, mx);
            const float alpha = __builtin_amdgcn_exp2f(m_run - m_new);
            m_run = m_new;
            float ls = 0.f;
#pragma unroll
            for (int r = 0; r < 16; ++r) { p0[r] = __builtin_amdgcn_exp2f(p0[r] - m_new); p1[r] = __builtin_amdgcn_exp2f(p1[r] - m_new); ls += p0[r] + p1[r]; }
            l_run = l_run * alpha + ls;
            if (__builtin_amdgcn_ballot_w64(alpha != 1.f) != 0ull) {
#pragma unroll
                for (int r = 0; r < 16; ++r) { o[0][r] *= alpha; o[1][r] *= alpha; }
            }
            u32x4 pw[4];
#pragma unroll
            for (int s = 0; s < 2; ++s) {
                pw[s] = (u32x4){pk2(p0[8 * s], p0[8 * s + 1]), pk2(p0[8 * s + 2], p0[8 * s + 3]), pk2(p0[8 * s + 4], p0[8 * s + 5]), pk2(p0[8 * s + 6], p0[8 * s + 7])};
                pw[2 + s] = (u32x4){pk2(p1[8 * s], p1[8 * s + 1]), pk2(p1[8 * s + 2], p1[8 * s + 3]), pk2(p1[8 * s + 4], p1[8 * s + 5]), pk2(p1[8 * s + 6], p1[8 * s + 7])};
            }
            const LAS unsigned char* vb = lds + VB0 + buf * VBSZ + ((lane >> 4) & 1) * 32 + (lane & 3) * 8 + (4 * hi + ((lane & 15) >> 2)) * 64;
            s16x4 vlo[8], vhi[8];
#pragma unroll
            for (int ks = 0; ks < 4; ++ks)
#pragma unroll
                for (int d0 = 0; d0 < 2; ++d0) { vlo[2 * ks + d0] = vtr(vb + d0 * 4096 + ks * 1024); vhi[2 * ks + d0] = vtr(vb + d0 * 4096 + ks * 1024 + 512); }
            __builtin_amdgcn_sched_barrier(0);
#pragma unroll
            for (int ks = 0; ks < 4; ++ks)
#pragma unroll
                for (int d0 = 0; d0 < 2; ++d0) {
                    const s16x4 lo = vlo[2 * ks + d0], hh = vhi[2 * ks + d0];
                    const bf16x8 vf = (bf16x8){lo[0], lo[1], lo[2], lo[3], hh[0], hh[1], hh[2], hh[3]};
                    o[d0] = __builtin_amdgcn_mfma_f32_32x32x16_bf16(vf, __builtin_bit_cast(bf16x8, pw[ks]), o[d0], 0, 0, 0);
                }
            __builtin_amdgcn_sched_barrier(0);
        }
        if (t + 2 < NT) ATT_STOREK(buf);
        if (t + 1 < NT) ATT_STOREV(buf ^ 1);
        __syncthreads();
        p0 = n0; p1 = n1;
    }
#undef ATT_LOADK
#undef ATT_LOADV
#undef ATT_STOREK
#undef ATT_STOREV
#undef ATT_QK
    const float inv = 1.0f / half_sum(l_run);
    float ss = 0.f;
#pragma unroll
    for (int r = 0; r < 16; ++r) { o[0][r] *= inv; o[1][r] *= inv; ss += o[0][r] * o[0][r] + o[1][r] * o[1][r]; }
    ss = half_sum(ss);
    const float rstd = __builtin_amdgcn_rsqf(ss * (1.f / 64.f) + RMS_EPS);
    bf16* OMr = (bf16*)(F.ws + R_OM) + (rowbase + q0 + wid * 32 + r32) * 1024 + (FOX ? h * 64 : 640 + h * 64) + 4 * hi;
#pragma unroll
    for (int d0 = 0; d0 < 2; ++d0)
#pragma unroll
        for (int g = 0; g < 4; ++g) {
            u32x2 w; w.x = pk2(o[d0][4 * g] * rstd, o[d0][4 * g + 1] * rstd); w.y = pk2(o[d0][4 * g + 2] * rstd, o[d0][4 * g + 3] * rstd);
            *(u32x2*)(OMr + 32 * d0 + 8 * g) = w;
        }
}

__device__ __forceinline__ void phase(const Ctx& F, int l) {
    unsigned* ctr = F.ctl + CW_AQ + 64 * l;
    for (;;) {
        if (F.tid == 0) F.MISC[4] = __hip_atomic_fetch_add(ctr, 1u, RLX_AGENT);
        __syncthreads();
        const int u = (int)F.MISC[4];
        __syncthreads();
        if (u >= 768) break;
        const int qb = 15 - u / 48, rem = u % 48, type = rem / 24, bh = rem % 24, b = bh / 6, h = bh % 6;
        if (type == 0) unit<false>(F, b, h, qb); else unit<true>(F, b, h, qb);
    }
}
}

__device__ __forceinline__ void moe_tables(const Ctx& F, int nN) {
    if (F.tid == 0) { int s = 0, up = 0;
        for (int e = 0; e < 8; ++e) { const int c = (int)__hip_atomic_load(F.ctl + CW_CNT + 64 * e, RLX_AGENT), nM = (c + 255) >> 8; F.TAB[e] = c; F.TAB[8 + e] = s; F.TAB[16 + e] = up; F.TAB[25 + e] = nM; s += c; up += nM * nN; }
        F.TAB[24] = up; }
    __syncthreads();
}

__global__ void __launch_bounds__(NWAVES * 64, 2) mk_fwd(Args args) {
    extern __shared__ __attribute__((aligned(16))) unsigned char lds_raw[];
    Ctx F;
    F.lds = (LAS unsigned char*)lds_raw; F.MISC = (volatile LAS unsigned*)(F.lds + MISC_OFF); F.TAB = (volatile LAS int*)(F.lds + TAB_OFF);
    F.tid = threadIdx.x; F.lane = F.tid & 63; F.wave = __builtin_amdgcn_readfirstlane(F.tid >> 6);
    { const int bx = blockIdx.x; F.vcu = (bx % 8) * (NBLK / 8) + bx / 8; }
    F.ws = args.ws; F.ctl = (unsigned*)(args.ws + WS_CTL); F.in = args.in; F.out = args.out;
    for (int u = F.tid; u < (LDS_BYTES - SCR_BYTES) / 4; u += NWAVES * 64) ((LAS unsigned*)(F.lds + SCR_BYTES))[u] = 0u;
    __syncthreads();
    const int lo = args.ph_lo, hi = args.ph_hi;
    XcdBarrier bar; bar.bar = F.ctl + CW_BAR; bar.x = 0; bar.st = nullptr;
    if (hi - lo > 1) bar = xcd_barrier_post(F.ctl + CW_BAR, F.MISC + 8);
    const int G = NBLK, cb = (int)blockIdx.x;

    for (int ph = lo; ph < hi; ++ph) {
        { int t_ = threadIdx.x; asm volatile("" : "+v"(t_)); F.tid = t_; F.lane = t_ & 63; F.wave = __builtin_amdgcn_readfirstlane(t_ >> 6); }
        const int nrep = ((REP_MASK >> ph) & 1) ? 2 : 1;
        for (int rep = 0; rep < nrep; ++rep) {
        if (ph == 0) { if (PHM(8)) p0a(F); }
        else if (ph == 1) { if (PHM(9)) row_phase<0, false, true>(F, 0); }
        else {
            const int l = (ph - 2) >> 3, s = (ph - 2) & 7; const bool moe = (l == 1);
            if (s == 0 && PHM(0)) {
                g8::SchedPlain S{(const char*)(F.ws + WS_H), (const char*)(F.ws + R_WIN) + (size_t)l * INP * 1024 * 2, T / 256, INP / 256, 1024, G, cb};
                g8::EpiIn E{(bf16*)(F.ws + R_FQ), (bf16*)(F.ws + R_FK), (bf16*)(F.ws + R_FV), (bf16*)(F.ws + R_KR), (bf16*)(F.ws + R_CONV3), (bf16*)(F.ws + R_CQ), (bf16*)(F.ws + R_CKV),
                            (float*)(F.ws + WS_LOGF), (float*)(F.ws + WS_SSQ), F.in[I_BF] + l * 6, (const f32x2*)(F.ws + WS_CS)};
                g8::gemm_phase<g8::EpiIn, g8::SchedPlain, false>(F.lds, F.tid, 1024, S, E);
                convert_experts(F, l == 0 ? 0 : 2);
            } else if (s == 1 && PHM(1)) {
#ifndef NO_SCANCONV
                scan_conv(F, l);
#endif
                { int t_ = threadIdx.x; asm volatile("" : "+v"(t_)); F.tid = t_; F.lane = t_ & 63; }
                { g8::SchedPlain S{(const char*)(F.ws + R_CQ), (const char*)(F.ws + R_WUQ) + (size_t)l * 768 * 256 * 2, T / 256, 3, 256, G, cb};
                  g8::EpiUp<0> E{(bf16*)(F.ws + R_QM), (bf16*)(F.ws + R_KVM), (const float*)(F.ws + WS_SSQ), (const f32x2*)(F.ws + WS_CS)};
                  g8::gemm_phase<g8::EpiUp<0>, g8::SchedPlain, false>(F.lds, F.tid, 256, S, E); }
                { int t_ = threadIdx.x; asm volatile("" : "+v"(t_)); F.tid = t_; F.lane = t_ & 63; }
                { g8::SchedPlain S{(const char*)(F.ws + R_CKV), (const char*)(F.ws + R_WUKV) + (size_t)l * 768 * 256 * 2, T / 256, 3, 256, G, (cb + 128) & 255};
                  g8::EpiUp<1> E{(bf16*)(F.ws + R_QM), (bf16*)(F.ws + R_KVM), (const float*)(F.ws + WS_SSQ), (const f32x2*)(F.ws + WS_CS)};
                  g8::gemm_phase<g8::EpiUp<1>, g8::SchedPlain, false>(F.lds, F.tid, 256, S, E); }
            } else if (s == 2 && PHM(2)) {
                att::phase(F, l + 2 * rep);
            } else if (s == 3 && PHM(3)) {
                g8::SchedPlain S{(const char*)(F.ws + R_OM), (const char*)(F.ws + R_WO) + (size_t)l * 1024 * 1024 * 2, T / 256, 4, 1024, G, cb};
                g8::EpiF32 E{(float*)(F.ws + R_Y), 1024};
                g8::gemm_phase<g8::EpiF32, g8::SchedPlain, false>(F.lds, F.tid, 1024, S, E);
            } else if (s == 4 && PHM(4)) {
                if (moe) row_phase<1, true, true>(F, l); else row_phase<1, false, true>(F, l);
            } else if (s == 5) {
                if (!moe) { if (PHM(5)) {
                    g8::SchedPlain S{(const char*)(F.ws + WS_H), (const char*)(F.ws + R_WGU), T / 256, 2 * DFF / 256, 1024, G, cb};
                    g8::EpiSwiGLU E{(bf16*)(F.ws + R_ACT), DFF};
                    g8::gemm_phase<g8::EpiSwiGLU, g8::SchedPlain, false>(F.lds, F.tid, 1024, S, E);
                    convert_experts(F, 1); }
                } else if (PHM(10)) {
                    moe_tables(F, 2 * DEXP / 256);
                    g8::SchedMoE S{(const char*)(F.ws + WS_H), (const char*)(F.ws + WS_WEGU), (size_t)7168 * 1024 * 2, (const int*)(F.ws + WS_ROWL), F.TAB, 2 * DEXP / 256, 1024, G, cb, true};
                    g8::EpiSwiGLU E{(bf16*)(F.ws + R_ACTM), DEXP};
                    g8::gemm_phase<g8::EpiSwiGLU, g8::SchedMoE, true>(F.lds, F.tid, 1024, S, E);
                }
            } else if (s == 6) {
                if (!moe) { if (PHM(6)) {
                    g8::SchedPlain S{(const char*)(F.ws + R_ACT), (const char*)(F.ws + R_WD), T / 256, 4, DFF, G, cb};
                    g8::EpiF32 E{(float*)(F.ws + R_Y), 1024};
                    g8::gemm_phase<g8::EpiF32, g8::SchedPlain, false>(F.lds, F.tid, DFF, S, E); }
                } else if (PHM(11)) {
                    moe_tables(F, 4);
                    g8::SchedMoE S{(const char*)(F.ws + R_ACTM), (const char*)(F.ws + WS_WED), (size_t)1024 * DEXP * 2, (const int*)(F.ws + WS_ROWL), F.TAB, 4, DEXP, G, cb, false};
                    g8::EpiBf16Rows E{(bf16*)(F.ws + WS_WEGU), 1024};
                    g8::gemm_phase<g8::EpiBf16Rows, g8::SchedMoE, false>(F.lds, F.tid, DEXP, S, E);
                }
            } else if (s == 7 && PHM(7)) {
                if (moe) row_phase<2, true, false>(F, l); else row_phase<2, false, true>(F, l);
            }
        }
        if (rep + 1 < nrep) xcd_barrier(bar);
        }
        if (ph + 1 < hi) xcd_barrier(bar);
    }
}

constexpr int N_PHASES = 18;
extern "C" void kernel_launch(void* const* d_in, const int* in_sizes, int n_in, void* d_out, int out_size, void* d_ws, size_t ws_size, hipStream_t stream) {
    static int ready = 0;
    if (ready == 0) {
        if (n_in != 24 || out_size != T * DM || ws_size < WS_END) { fprintf(stderr, "kernel_launch: unexpected problem (n_in %d, out %d, ws %zu < %zu)\n", n_in, out_size, ws_size, (size_t)WS_END); ready = -1; return; }
        if (hipFuncSetAttribute((const void*)mk_fwd, hipFuncAttributeMaxDynamicSharedMemorySize, LDS_BYTES) != hipSuccess) { fprintf(stderr, "kernel_launch: hipFuncSetAttribute failed\n"); ready = -1; return; }
        int per_cu = 0;
        if (hipOccupancyMaxActiveBlocksPerMultiprocessor(&per_cu, (const void*)mk_fwd, NWAVES * 64, LDS_BYTES) != hipSuccess || per_cu < 1) fprintf(stderr, "kernel_launch: occupancy query reports %d\n", per_cu);
        (void)hipGetLastError();
        ready = 1;
    }
    if (ready < 0) return;
    (void)hipMemsetAsync((char*)d_ws + WS_CTL, 0, CTL_ZERO_BYTES, stream);
    Args a{};
    for (int i = 0; i < 24; ++i) a.in[i] = (const float*)d_in[i];
    a.out = (float*)d_out; a.ws = (unsigned char*)d_ws;
#if MK_N_LAUNCHES == 1
    a.ph_lo = 0; a.ph_hi = N_PHASES;
    hipLaunchKernelGGL(mk_fwd, dim3(NBLK), dim3(NWAVES * 64), LDS_BYTES, stream, a);
#else
    for (int p = 0; p < N_PHASES; ++p) { a.ph_lo = p; a.ph_hi = p + 1; hipLaunchKernelGGL(mk_fwd, dim3(NBLK), dim3(NWAVES * 64), LDS_BYTES, stream, a); }
#endif
}
```

```cpp
#include <hip/hip_runtime.h>
#include <cstdio>
#include <cstdint>

#ifndef MK_N_LAUNCHES
#define MK_N_LAUNCHES 1
#endif

#ifndef PH_MASK
#define PH_MASK 0xFFF
#endif
#define PHM(k) ((PH_MASK >> (k)) & 1)
#ifndef EXPERT_SLOTS
#define EXPERT_SLOTS 1
#endif
#ifndef REP_MASK
#define REP_MASK 0
#endif
#define LAS __attribute__((address_space(3)))
typedef unsigned short bf16;
typedef short bf16x8 __attribute__((ext_vector_type(8)));
typedef short s16x4 __attribute__((ext_vector_type(4)));
typedef float f32x2 __attribute__((ext_vector_type(2)));
typedef float f32x4 __attribute__((ext_vector_type(4)));
typedef float f32x16 __attribute__((ext_vector_type(16)));
typedef unsigned u32x2 __attribute__((ext_vector_type(2)));
typedef unsigned u32x4 __attribute__((ext_vector_type(4)));
typedef __bf16 bf16x2_t __attribute__((ext_vector_type(2)));

constexpr int DM = 1024, NBATCH = 4, SEQ = 4096, T = NBATCH * SEQ;
constexpr int HF = 6, HM = 6;
constexpr int INW = 2470, INP = 2560;
constexpr int DFF = 2816, NE = 8, DEXP = 3584;
constexpr int NBLK = 256, NWAVES = 8;
constexpr float LOG2E = 1.4426950408889634f;
constexpr float C2F = 0.125f * LOG2E;
constexpr float C2M = 0.10206207261596575f * LOG2E;
constexpr float ALPHA = 1.4142135623730951f;
constexpr float LN_EPS = 1e-5f, RMS_EPS = 1e-6f;

constexpr size_t MiB = 1u << 20, KiB = 1024;
constexpr size_t WS_CTL = 0, CTL_ZERO_BYTES = 1 * MiB;
constexpr size_t WS_MOD = 1 * MiB;
constexpr size_t WS_CS = WS_MOD + 1024 * KiB;
constexpr size_t WS_G = WS_CS + 512 * KiB;
constexpr size_t WS_LOGF = WS_G + 512 * KiB;
constexpr size_t WS_SSQ = WS_LOGF + 512 * KiB;
constexpr size_t WS_ROWL = WS_SSQ + 512 * KiB;
constexpr size_t WS_TOKP = WS_ROWL + 512 * KiB;
constexpr size_t WS_TOKW = WS_TOKP + 128 * KiB;
constexpr size_t WS_WEGU = 8 * MiB;
constexpr size_t WS_WED = 120 * MiB;
constexpr size_t WS_RA = 176 * MiB;
constexpr size_t WS_H = 240 * MiB;
constexpr size_t WS_R = 272 * MiB;
constexpr size_t WS_END = 498 * MiB;
constexpr size_t R_WIN = WS_R, R_WUQ = WS_R + 10 * MiB, R_WUKV = R_WUQ + 768 * KiB, R_WO = R_WUKV + 768 * KiB, R_WGU = R_WO + 4 * MiB, R_WD = R_WGU + 11 * MiB;
constexpr size_t R_Y = WS_R + 32 * MiB;
constexpr size_t R_CONV3 = WS_R + 32 * MiB, R_CQ = WS_R + 56 * MiB, R_CKV = WS_R + 64 * MiB, R_QM = WS_R + 72 * MiB, R_KVM = WS_R + 90 * MiB, R_OM = WS_R + 114 * MiB;
constexpr size_t R_FQ = WS_R + 146 * MiB, R_FK = WS_R + 158 * MiB, R_FV = WS_R + 170 * MiB, R_KR = WS_R + 182 * MiB;
constexpr size_t R_ACT = WS_R + 96 * MiB;
constexpr size_t R_ACTM = WS_R;
static_assert(R_WD + (size_t)DM * DFF * 2 <= R_Y, "weights fit");
static_assert(R_ACT + (size_t)T * DFF * 2 <= WS_END && R_ACTM + (size_t)(32768 + 256) * DEXP * 2 <= WS_END, "act fits");
constexpr int CW_BAR = 4096, CW_CNT = 8192, CW_AQ = 9216;

constexpr int RING_BYTES = 131072, SCR_BYTES = 135168  , MISC_OFF = SCR_BYTES + 320, TAB_OFF = SCR_BYTES + 1024, LDS_BYTES = 147456;
static_assert(8 * 16640 <= SCR_BYTES, "prologue scratch");

__device__ __forceinline__ unsigned pk2(float lo, float hi) { f32x2 v = {lo, hi}; bf16x2_t b = __builtin_convertvector(v, bf16x2_t); return __builtin_bit_cast(unsigned, b); }
__device__ __forceinline__ float bflo(unsigned u) { return __uint_as_float(u << 16); }
__device__ __forceinline__ float bfhi(unsigned u) { return __uint_as_float(u & 0xffff0000u); }
__device__ __forceinline__ float lane_get(float v, int src) { return __int_as_float(__builtin_amdgcn_ds_bpermute(src << 2, __float_as_int(v))); }
__device__ __forceinline__ float lane_xor(float v, int lane, int o) { return lane_get(v, lane ^ o); }
__device__ __forceinline__ float wave_sum(float v, int lane) {
#pragma unroll
    for (int o = 1; o < 64; o <<= 1) v += lane_xor(v, lane, o);
    return v;
}
#define LDS_WAIT() asm volatile("s_waitcnt lgkmcnt(0)" ::: "memory")
#define VM_WAIT() asm volatile("s_waitcnt vmcnt(0)" ::: "memory")
#define RLX_AGENT __ATOMIC_RELAXED, __HIP_MEMORY_SCOPE_AGENT

namespace g8 {
constexpr int BM = 256, BK = 64, HALF = 128, HTB = HALF * BK * 2, STAGE_BYTES = 8 * HTB, NXCD = 8, WGM = 8;
__host__ __device__ __forceinline__ int lds_byte(int r, int c) { const int st = (r >> 4) * 2 + (c >> 5), rr = r & 15, cc = c & 31, ob = rr * 64 + cc * 2; return st * 1024 + (ob ^ (((ob >> 9) & 1) << 5)); }
__host__ __device__ __forceinline__ void stage_rc(int b, int& R, int& C) { const int st = b / 1024, sb = b % 1024, swz = sb ^ (((sb >> 9) & 1) << 5); R = (st >> 1) * 16 + swz / 64; C = (st & 1) * 32 + (swz % 64) / 2; }
__host__ __device__ __forceinline__ int perm32(int rho) { const int n = rho >> 4, i = rho & 15; return 8 * (i >> 2) + 4 * n + (i & 3); }

struct Unit { int pm, pn, grp, mvalid, rowbase; const char* a; const char* b; const int* rl; };

__device__ __forceinline__ int xcd_remap(int wgid, int nwg) { const int q = nwg / NXCD, r = nwg % NXCD, xcd = wgid % NXCD, off = wgid / NXCD; return (xcd < r ? xcd * (q + 1) : r * (q + 1) + (xcd - r) * q) + off; }
__device__ __forceinline__ void grouped_pmpn(int local, int nM, int nN, int& pm, int& pn) {
    const int nig = WGM * nN, gid = local / nig, fm = gid * WGM, gsz = (nM - fm) < WGM ? (nM - fm) : WGM;
    pm = fm + ((local % nig) % gsz); pn = (local % nig) / gsz;
}
struct SchedPlain {
    const char* A; const char* Bt; int nM, nN, K, G, c;
    __device__ __forceinline__ bool next(int i, Unit& u) const {
        const int nwg = nM * nN; const long L = (long)i * G + c; if (L >= nwg) return false;
        const int wgid = xcd_remap((int)L, nwg); int pm, pn; grouped_pmpn(wgid, nM, nN, pm, pn);
        u.pm = pm; u.pn = pn; u.grp = 0; u.mvalid = 256; u.rowbase = pm * 256; u.a = A + (size_t)pm * 256 * K * 2; u.b = Bt + (size_t)pn * 256 * K * 2; u.rl = nullptr; return true;
    }
};
struct SchedPair {
    const char* A0; const char* B0; const char* A1; const char* B1; int nM, nN, K, G, c;
    __device__ __forceinline__ bool next(int i, Unit& u) const {
        const int per = nM * nN, nwg = 2 * per; const long L = (long)i * G + c; if (L >= nwg) return false;
        const int wgid = xcd_remap((int)L, nwg); const int grp = wgid / per; int pm, pn; grouped_pmpn(wgid % per, nM, nN, pm, pn);
        u.pm = pm; u.pn = pn; u.grp = grp; u.mvalid = 256; u.rowbase = pm * 256;
        u.a = (grp ? A1 : A0) + (size_t)pm * 256 * K * 2; u.b = (grp ? B1 : B0) + (size_t)pn * 256 * K * 2; u.rl = nullptr; return true;
    }
};
struct SchedMoE {
    const char* A; const char* Bt; size_t bexp; const int* rowl; volatile LAS int* tab; int nN, K, G, c; bool gather; int limit;
    __device__ __forceinline__ int tb(int i) const { return __builtin_amdgcn_readfirstlane(tab[i]); }
    __device__ __forceinline__ bool next(int i, Unit& u) const {
        const int nwg = limit < 0 ? tb(24) : limit; const long L = (long)i * G + c; if (L >= nwg) return false;
        const int wgid = xcd_remap((int)L, nwg);
        int e = 0;
#pragma unroll
        for (int j = 1; j < 8; ++j) if (wgid >= tb(16 + j)) e = j;
        const int local = wgid - tb(16 + e), nM = tb(25 + e), cnt = tb(e), start = tb(8 + e);
        int pm, pn; grouped_pmpn(local, nM, nN, pm, pn);
        u.pm = pm; u.pn = pn; u.grp = e; u.mvalid = (cnt - pm * 256) < 256 ? (cnt - pm * 256) : 256; u.rowbase = start + pm * 256;
        u.a = gather ? A : A + (size_t)(start + pm * 256) * K * 2; u.b = Bt + (size_t)e * bexp + (size_t)pn * 256 * K * 2; u.rl = rowl + e * 16384 + pm * 256; return true;
    }
};

struct SchedMoETail {
    const char* A; const char* Bt; size_t bexp; volatile LAS int* tab; int nN, K, c;
    __device__ __forceinline__ int tb(int i) const { return __builtin_amdgcn_readfirstlane(tab[i]); }
    __device__ __forceinline__ bool next(int i, Unit& u) const {
        if (i > 0 || c >= tb(34)) return false;
        const int SK = tb(35), wgid = tb(33) + c / SK, s = c % SK, ksub = K / SK;
        int e = 0;
#pragma unroll
        for (int j = 1; j < 8; ++j) if (wgid >= tb(16 + j)) e = j;
        const int local = wgid - tb(16 + e), nM = tb(25 + e), start = tb(8 + e);
        int pm, pn; grouped_pmpn(local, nM, nN, pm, pn);
        u.pm = pm; u.pn = pn; u.grp = c; u.mvalid = 256; u.rowbase = 0;
        u.a = A + (size_t)(start + pm * 256) * K * 2 + (size_t)s * ksub * 2; u.b = Bt + (size_t)e * bexp + (size_t)pn * 256 * K * 2 + (size_t)s * ksub * 2; u.rl = nullptr; return true;
    }
};

template <class Epi, class Sched, bool GATHER>
__device__ __forceinline__ void gemm_phase(LAS unsigned char* lds, const int tid, const int K  , const int klen  , const Sched& S, const Epi& E) {
    const int wid = __builtin_amdgcn_readfirstlane(tid >> 6), lane = tid & 63, wr = wid >> 2, wc = wid & 3, fr = lane & 15, fq = lane >> 4;
    const int nt = klen / BK;
    int RA[2], CA[2]; unsigned voffB[2];
#pragma unroll
    for (int i = 0; i < 2; ++i) { int R, C; stage_rc(tid * 16 + i * 8192, R, C); const int Rb = Epi::PERM ? ((R & ~31) + perm32(R & 31)) : R; RA[i] = R; CA[i] = C; voffB[i] = (unsigned)(Rb * K + C) * 2u; }
    const size_t kstep = (size_t)(BK * 2);
    const size_t hstep = (size_t)HALF * K * 2;
    const unsigned ldsw = (unsigned)wid * 1024u;
    const int aoff = lds_byte(wr * 64 + fr, fq * 8), boff = lds_byte(wc * 32 + fr, fq * 8);
#define G8_SA(b, h) (((b) * 2 + (h)) * HTB)
#define G8_SB(b, h) ((4 + (b) * 2 + (h)) * HTB)
#define G8_STAGE_B(bufoff, gbase) do { _Pragma("unroll") for (int _i = 0; _i < 2; ++_i) \
        __builtin_amdgcn_global_load_lds((const unsigned*)((const char*)(gbase) + voffB[_i]), (LAS unsigned*)(lds + (bufoff) + ldsw + _i * 8192), 16, 0, 0); } while (0)
#define G8_STAGE_A(bufoff, gbase, AO, h) do { _Pragma("unroll") for (int _i = 0; _i < 2; ++_i) \
        __builtin_amdgcn_global_load_lds((const unsigned*)((const char*)(gbase) + AO[h][_i]), (LAS unsigned*)(lds + (bufoff) + ldsw + _i * 8192), 16, 0, 0); } while (0)
#define G8_LDA(dst, b, h) do { _Pragma("unroll") for (int m = 0; m < 4; ++m) _Pragma("unroll") for (int k = 0; k < 2; ++k) dst[m][k] = *(const LAS bf16x8*)(lds + G8_SA(b, h) + aoff + m * 2048 + k * 1024); } while (0)
#define G8_LDB(dst, b, h) do { _Pragma("unroll") for (int n = 0; n < 2; ++n) _Pragma("unroll") for (int k = 0; k < 2; ++k) dst[n][k] = *(const LAS bf16x8*)(lds + G8_SB(b, h) + boff + n * 2048 + k * 1024); } while (0)
#define G8_MMA(ai, bj, At, Bt) do { __builtin_amdgcn_s_setprio(1); _Pragma("unroll") for (int m = 0; m < 4; ++m) _Pragma("unroll") for (int n = 0; n < 2; ++n) _Pragma("unroll") for (int k = 0; k < 2; ++k) \
        acc[ai][bj][m][n] = __builtin_amdgcn_mfma_f32_16x16x32_bf16(Bt[n][k], At[m][k], acc[ai][bj][m][n], 0, 0, 0); __builtin_amdgcn_s_setprio(0); } while (0)
#define G8_WAIT_V(n) asm volatile("s_waitcnt vmcnt(" #n ")" ::: "memory")
#define G8_WAIT_L(n) asm volatile("s_waitcnt lgkmcnt(" #n ")" ::: "memory")
#define G8_BAR __builtin_amdgcn_s_barrier()
#define G8_SCHED __builtin_amdgcn_sched_barrier(0)
#define G8_AOFF(AO, U) do { _Pragma("unroll") for (int _h = 0; _h < 2; ++_h) _Pragma("unroll") for (int _i = 0; _i < 2; ++_i) { \
        if constexpr (GATHER) { const int _r = _h * HALF + RA[_i]; const int _tok = (_r < (U).mvalid) ? (U).rl[_r] : 0; AO[_h][_i] = (unsigned)_tok * (unsigned)(K * 2) + (unsigned)(CA[_i] * 2); } \
        else AO[_h][_i] = (unsigned)((_h * HALF + RA[_i]) * K + CA[_i]) * 2u; } } while (0)
    Unit cur, nxt; int ui = 0;
    if (!S.next(0, cur)) return;
    f32x4 acc[2][2][4][2];
#pragma unroll
    for (int a = 0; a < 2; ++a)
#pragma unroll
        for (int b = 0; b < 2; ++b)
#pragma unroll
            for (int m = 0; m < 4; ++m)
#pragma unroll
                for (int n = 0; n < 2; ++n) acc[a][b][m][n] = (f32x4){0.f, 0.f, 0.f, 0.f};
    bf16x8 At[4][2], B0[2][2], B1[2][2];
    unsigned aoc[2][2], aon[2][2];
    G8_AOFF(aoc, cur);
    if constexpr (GATHER) { VM_WAIT(); }
    const char* cA = cur.a; const char* cB = cur.b;
    G8_STAGE_B(G8_SB(0, 0), cB); G8_STAGE_B(G8_SB(0, 1), cB + hstep); G8_STAGE_A(G8_SA(0, 0), cA, aoc, 0); G8_STAGE_A(G8_SA(0, 1), cA, aoc, 1);
    if (wr == 1) G8_BAR;
    G8_WAIT_V(2); G8_BAR;
    G8_STAGE_B(G8_SB(1, 0), cB + kstep); G8_STAGE_A(G8_SA(1, 0), cA + kstep, aoc, 0); G8_STAGE_B(G8_SB(1, 1), cB + hstep + kstep);
    G8_WAIT_V(6); G8_BAR;
    for (;;) {
        const bool has_next = S.next(ui + 1, nxt);
        const char* nA = has_next ? nxt.a : cA; const char* nB = has_next ? nxt.b : cB;
        if constexpr (GATHER) {
            if (has_next) { G8_AOFF(aon, nxt); }
            else {
#pragma unroll
                for (int h = 0; h < 2; ++h)
#pragma unroll
                    for (int i = 0; i < 2; ++i) aon[h][i] = aoc[h][i];
            }
        }
#pragma unroll 1
        for (int t = 0; t < nt; t += 2) {
            const bool last = (t == nt - 2);
            const char* a1 = cA + (size_t)(t + 1) * kstep;
            const char* a2 = last ? nA : cA + (size_t)(t + 2) * kstep; const char* b2 = last ? nB : cB + (size_t)(t + 2) * kstep;
            const char* a3 = a2 + kstep; const char* b3 = b2 + kstep;
            unsigned ao2[2][2];
#pragma unroll
            for (int h = 0; h < 2; ++h)
#pragma unroll
                for (int i = 0; i < 2; ++i) { if constexpr (GATHER) ao2[h][i] = last ? aon[h][i] : aoc[h][i]; else ao2[h][i] = aoc[h][i]; }
            G8_LDB(B0, 0, 0); G8_LDB(B1, 0, 1); G8_SCHED; G8_LDA(At, 0, 0); G8_STAGE_A(G8_SA(1, 1), a1, aoc, 1);
            G8_WAIT_V(8); G8_WAIT_L(0); G8_BAR; G8_MMA(0, 0, At, B0); G8_MMA(0, 1, At, B1); G8_BAR; G8_SCHED;
            G8_LDA(At, 0, 1); G8_STAGE_B(G8_SB(0, 0), b2); G8_STAGE_B(G8_SB(0, 1), b2 + hstep); G8_STAGE_A(G8_SA(0, 0), a2, ao2, 0);
            G8_WAIT_V(8); G8_WAIT_L(0); G8_BAR; G8_MMA(1, 0, At, B0); G8_MMA(1, 1, At, B1); G8_BAR; G8_SCHED;
            G8_LDB(B0, 1, 0); G8_LDB(B1, 1, 1); G8_SCHED; G8_LDA(At, 1, 0); G8_STAGE_A(G8_SA(0, 1), a2, ao2, 1);
            G8_WAIT_V(8); G8_WAIT_L(0); G8_BAR; G8_MMA(0, 0, At, B0); G8_MMA(0, 1, At, B1); G8_BAR; G8_SCHED;
            G8_LDA(At, 1, 1); G8_STAGE_B(G8_SB(1, 0), b3); G8_STAGE_B(G8_SB(1, 1), b3 + hstep); G8_STAGE_A(G8_SA(1, 0), a3, ao2, 0);
            G8_WAIT_V(8); G8_WAIT_L(0); G8_BAR; G8_MMA(1, 0, At, B0); G8_MMA(1, 1, At, B1); G8_BAR; G8_SCHED;
        }
        if (wr == 0) G8_BAR;
        E(acc, cur, wr, wc, fr, fq);
        if (!has_next) break;
#pragma unroll
        for (int a = 0; a < 2; ++a)
#pragma unroll
            for (int b = 0; b < 2; ++b)
#pragma unroll
                for (int m = 0; m < 4; ++m)
#pragma unroll
                    for (int n = 0; n < 2; ++n) acc[a][b][m][n] = (f32x4){0.f, 0.f, 0.f, 0.f};
        cur = nxt; cA = nA; cB = nB; ++ui;
        if constexpr (GATHER) {
#pragma unroll
            for (int h = 0; h < 2; ++h)
#pragma unroll
                for (int i = 0; i < 2; ++i) aoc[h][i] = aon[h][i];
        }
        if (wr == 1) G8_BAR;
    }
    G8_WAIT_V(0);
    G8_BAR;
#undef G8_SA
#undef G8_SB
#undef G8_STAGE_A
#undef G8_STAGE_B
#undef G8_LDA
#undef G8_LDB
#undef G8_MMA
#undef G8_WAIT_V
#undef G8_WAIT_L
#undef G8_BAR
#undef G8_SCHED
#undef G8_AOFF
}

__device__ __forceinline__ float log_sigmoid(float x) { return fminf(x, 0.f) - __logf(1.f + __expf(-fabsf(x))); }
__device__ __forceinline__ float silu_mul(float g, float u) { return g * u * __builtin_amdgcn_rcpf(1.f + __builtin_amdgcn_exp2f(-LOG2E * g)); }

struct EpiIn {
    static constexpr bool PERM = true;
    bf16 *FQ, *FK, *FV, *KR, *CONV3, *CQ, *CKV; float* LOGF; float* SSQ; const float* bf; const f32x2* CS;
    __device__ __forceinline__ void operator()(const f32x4 (&acc)[2][2][4][2], const Unit& u, int wr, int wc, int fr, int fq) const {
        asm volatile("" : "+v"(fr), "+v"(fq));
        const int row0 = u.pm * 256 + wr * 64 + fr;
#pragma unroll
        for (int bj = 0; bj < 2; ++bj) {
            const int hb = 2 * u.pn + bj;
            if (hb == 9) {
                if (wc == 0) {
#pragma unroll
                    for (int ai = 0; ai < 2; ++ai)
#pragma unroll
                        for (int m = 0; m < 4; ++m) {
                            const int row = row0 + ai * 128 + m * 16, t = row & (SEQ - 1);
                            const f32x4 v0 = acc[ai][bj][m][0], v1 = acc[ai][bj][m][1];
                            const f32x4 c01 = *(const f32x4*)(CS + t * 16 + 4 * fq), c23 = *(const f32x4*)(CS + t * 16 + 4 * fq + 2);
                            u32x4 w;
                            w.x = pk2(v0[0] * c01[0] - v0[1] * c01[1], v0[1] * c01[0] + v0[0] * c01[1]);
                            w.y = pk2(v0[2] * c01[2] - v0[3] * c01[3], v0[3] * c01[2] + v0[2] * c01[3]);
                            w.z = pk2(v1[0] * c23[0] - v1[1] * c23[1], v1[1] * c23[0] + v1[0] * c23[1]);
                            w.w = pk2(v1[2] * c23[2] - v1[3] * c23[3], v1[3] * c23[2] + v1[2] * c23[3]);
                            *(u32x4*)(KR + (size_t)row * 32 + 8 * fq) = w;
                        }
                } else if (wc == 1) {
                    if (fq == 0) {
#pragma unroll
                        for (int ai = 0; ai < 2; ++ai)
#pragma unroll
                            for (int m = 0; m < 4; ++m) {
                                const int row = row0 + ai * 128 + m * 16;
                                const f32x4 v0 = acc[ai][bj][m][0], v1 = acc[ai][bj][m][1];
                                f32x4 o0, o1;
                                o0[0] = log_sigmoid(v0[0] + bf[0]); o0[1] = log_sigmoid(v0[1] + bf[1]); o0[2] = log_sigmoid(v0[2] + bf[2]); o0[3] = log_sigmoid(v0[3] + bf[3]);
                                o1[0] = log_sigmoid(v1[0] + bf[4]); o1[1] = log_sigmoid(v1[1] + bf[5]); o1[2] = 0.f; o1[3] = 0.f;
                                *(f32x4*)(LOGF + (size_t)row * 8) = o0; *(f32x4*)(LOGF + (size_t)row * 8 + 4) = o1;
                            }
                    }
                }
                continue;
            }
            bf16* base; int ld, colo; float sc = 1.f;
            if (hb < 3) { base = FQ; ld = 384; colo = 128 * hb; sc = C2F; }
            else if (hb < 6) { base = FK; ld = 384; colo = 128 * (hb - 3); }
            else if (hb < 9) { base = FV; ld = 384; colo = 128 * (hb - 6); }
            else if (hb < 16) { base = CONV3; ld = 768; colo = 128 * (hb - 10); }
            else if (hb < 18) { base = CQ; ld = 256; colo = 128 * (hb - 16); }
            else { base = CKV; ld = 256; colo = 128 * (hb - 18); }
            const int col = colo + wc * 32 + 8 * fq;
#pragma unroll
            for (int ai = 0; ai < 2; ++ai)
#pragma unroll
                for (int m = 0; m < 4; ++m) {
                    const int row = row0 + ai * 128 + m * 16;
                    const f32x4 v0 = acc[ai][bj][m][0] * sc, v1 = acc[ai][bj][m][1] * sc;
                    u32x4 w; w.x = pk2(v0[0], v0[1]); w.y = pk2(v0[2], v0[3]); w.z = pk2(v1[0], v1[1]); w.w = pk2(v1[2], v1[3]);
                    *(u32x4*)(base + (size_t)row * ld + col) = w;
                }
        }
        if (u.pn >= 8) {
            float* sq = SSQ + (size_t)(u.pn - 8) * T * 4;
#pragma unroll
            for (int ai = 0; ai < 2; ++ai)
#pragma unroll
                for (int m = 0; m < 4; ++m) {
                    float s = 0.f;
#pragma unroll
                    for (int bj = 0; bj < 2; ++bj)
#pragma unroll
                        for (int n = 0; n < 2; ++n) { const f32x4 x = acc[ai][bj][m][n]; s += (x[0] * x[0] + x[1] * x[1]) + (x[2] * x[2] + x[3] * x[3]); }
                    s += lane_xor(s, fq * 16 + fr, 16); s += lane_xor(s, fq * 16 + fr, 32);
                    if (fq == 0) sq[(size_t)(row0 + ai * 128 + m * 16) * 4 + wc] = s;
                }
        }
    }
};

template <int GRP> struct EpiUp {
    static constexpr bool PERM = true;
    bf16 *QM, *KVM; const float* SSQ; const f32x2* CS;
    __device__ __forceinline__ void operator()(const f32x4 (&acc)[2][2][4][2], const Unit& u, int wr, int wc, int fr, int fq) const {
        asm volatile("" : "+v"(fr), "+v"(fq));
        const int row0 = u.pm * 256 + wr * 64 + fr;
        const float* sq = SSQ + (size_t)GRP * T * 4;
#pragma unroll
        for (int ai = 0; ai < 2; ++ai)
#pragma unroll
            for (int m = 0; m < 4; ++m) {
                const int row = row0 + ai * 128 + m * 16, t = row & (SEQ - 1);
                const f32x4 p = *(const f32x4*)(sq + (size_t)row * 4);
                const float rstd = __builtin_amdgcn_rsqf(((p[0] + p[1]) + (p[2] + p[3])) * (1.f / 256.f) + RMS_EPS);
#pragma unroll
                for (int bj = 0; bj < 2; ++bj) {
                    const int col = u.pn * 256 + bj * 128 + wc * 32 + 8 * fq;
                    if (GRP == 0) {
                        if (col < 576) {
                            const float s = rstd * C2M;
                            f32x4 v0 = acc[ai][bj][m][0] * s, v1 = acc[ai][bj][m][1] * s;
                            const int j = col % 96;
                            if (j >= 64) {
                                const int pi = (j - 64) >> 1;
                                const f32x4 c01 = *(const f32x4*)(CS + t * 16 + pi), c23 = *(const f32x4*)(CS + t * 16 + pi + 2);
                                f32x4 r0, r1;
                                r0[0] = v0[0] * c01[0] - v0[1] * c01[1]; r0[1] = v0[1] * c01[0] + v0[0] * c01[1];
                                r0[2] = v0[2] * c01[2] - v0[3] * c01[3]; r0[3] = v0[3] * c01[2] + v0[2] * c01[3];
                                r1[0] = v1[0] * c23[0] - v1[1] * c23[1]; r1[1] = v1[1] * c23[0] + v1[0] * c23[1];
                                r1[2] = v1[2] * c23[2] - v1[3] * c23[3]; r1[3] = v1[3] * c23[2] + v1[2] * c23[3];
                                v0 = r0; v1 = r1;
                            }
                            u32x4 w; w.x = pk2(v0[0], v0[1]); w.y = pk2(v0[2], v0[3]); w.z = pk2(v1[0], v1[1]); w.w = pk2(v1[2], v1[3]);
                            *(u32x4*)(QM + (size_t)row * 576 + col) = w;
                        }
                    } else {
                        const f32x4 v0 = acc[ai][bj][m][0] * rstd, v1 = acc[ai][bj][m][1] * rstd;
                        u32x4 w; w.x = pk2(v0[0], v0[1]); w.y = pk2(v0[2], v0[3]); w.z = pk2(v1[0], v1[1]); w.w = pk2(v1[2], v1[3]);
                        *(u32x4*)(KVM + (size_t)row * 768 + col) = w;
                    }
                }
                asm volatile("" ::: "memory"); __builtin_amdgcn_sched_barrier(0);
            }
    }
};

struct EpiF32 {
    static constexpr bool PERM = false;
    float* Y; int ldc;
    __device__ __forceinline__ void operator()(const f32x4 (&acc)[2][2][4][2], const Unit& u, int wr, int wc, int fr, int fq) const {
        asm volatile("" : "+v"(fr), "+v"(fq));
        const int row0 = u.pm * 256 + wr * 64 + fr, col0 = u.pn * 256 + wc * 32 + 4 * fq;
#pragma unroll
        for (int ai = 0; ai < 2; ++ai)
#pragma unroll
            for (int m = 0; m < 4; ++m) { float* rp = Y + (size_t)(row0 + ai * 128 + m * 16) * ldc + col0;
#pragma unroll
                for (int bj = 0; bj < 2; ++bj)
#pragma unroll
                    for (int n = 0; n < 2; ++n) *(f32x4*)(rp + bj * 128 + n * 16) = acc[ai][bj][m][n]; }
    }
};

struct EpiSwiGLU {
    static constexpr bool PERM = true;
    bf16* ACT; int ld;
    __device__ __forceinline__ void operator()(const f32x4 (&acc)[2][2][4][2], const Unit& u, int wr, int wc, int fr, int fq) const {
        asm volatile("" : "+v"(fr), "+v"(fq));
        const int col = u.pn * 128 + wc * 32 + 8 * fq;
#pragma unroll
        for (int ai = 0; ai < 2; ++ai)
#pragma unroll
            for (int m = 0; m < 4; ++m) {
                const int rt = ai * 128 + wr * 64 + m * 16 + fr;
                if (rt < u.mvalid) {
                    const f32x4 g0 = acc[ai][0][m][0], g1 = acc[ai][0][m][1], u0 = acc[ai][1][m][0], u1 = acc[ai][1][m][1];
                    u32x4 w;
                    w.x = pk2(silu_mul(g0[0], u0[0]), silu_mul(g0[1], u0[1])); w.y = pk2(silu_mul(g0[2], u0[2]), silu_mul(g0[3], u0[3]));
                    w.z = pk2(silu_mul(g1[0], u1[0]), silu_mul(g1[1], u1[1])); w.w = pk2(silu_mul(g1[2], u1[2]), silu_mul(g1[3], u1[3]));
                    *(u32x4*)(ACT + (size_t)(u.rowbase + rt) * ld + col) = w;
                }
                asm volatile("" ::: "memory"); __builtin_amdgcn_sched_barrier(0);
            }
    }
};

struct EpiBf16Rows {
    static constexpr bool PERM = true;
    bf16* O; int ld;
    __device__ __forceinline__ void operator()(const f32x4 (&acc)[2][2][4][2], const Unit& u, int wr, int wc, int fr, int fq) const {
        asm volatile("" : "+v"(fr), "+v"(fq));
#pragma unroll
        for (int ai = 0; ai < 2; ++ai)
#pragma unroll
            for (int m = 0; m < 4; ++m) {
                const int rt = ai * 128 + wr * 64 + m * 16 + fr;
                if (rt < u.mvalid) {
#pragma unroll
                    for (int bj = 0; bj < 2; ++bj) {
                        const f32x4 v0 = acc[ai][bj][m][0], v1 = acc[ai][bj][m][1];
                        u32x4 w; w.x = pk2(v0[0], v0[1]); w.y = pk2(v0[2], v0[3]); w.z = pk2(v1[0], v1[1]); w.w = pk2(v1[2], v1[3]);
                        *(u32x4*)(O + (size_t)(u.rowbase + rt) * ld + u.pn * 256 + bj * 128 + wc * 32 + 8 * fq) = w;
                    }
                }
                asm volatile("" ::: "memory"); __builtin_amdgcn_sched_barrier(0);
            }
    }
};
struct EpiSlab {
    static constexpr bool PERM = true;
    bf16* O;
    __device__ __forceinline__ void operator()(const f32x4 (&acc)[2][2][4][2], const Unit& u, int wr, int wc, int fr, int fq) const {
        asm volatile("" : "+v"(fr), "+v"(fq));
        bf16* base = O + (size_t)u.grp * 65536;
#pragma unroll
        for (int ai = 0; ai < 2; ++ai)
#pragma unroll
            for (int m = 0; m < 4; ++m) {
                const int rt = ai * 128 + wr * 64 + m * 16 + fr;
#pragma unroll
                for (int bj = 0; bj < 2; ++bj) {
                    const f32x4 v0 = acc[ai][bj][m][0], v1 = acc[ai][bj][m][1];
                    u32x4 w; w.x = pk2(v0[0], v0[1]); w.y = pk2(v0[2], v0[3]); w.z = pk2(v1[0], v1[1]); w.w = pk2(v1[2], v1[3]);
                    *(u32x4*)(base + rt * 256 + bj * 128 + wc * 32 + 8 * fq) = w;
                }
                asm volatile("" ::: "memory"); __builtin_amdgcn_sched_barrier(0);
            }
    }
};
}

#define XB_TMO      128
#define XB_XCNT(j)  (256  + 64 * (j))
#define XB_XSUB(j)  (1280 + 64 * (j))
#define XB_XGEN(j)  (2304 + 64 * (j))
#define XB_TOP      3328
#define XB_TOPGEN   3392
#define XCD_BAR_WORDS 3456
#define XB_SPIN_CAP (1u << 20)
__device__ __forceinline__ unsigned xb_ld(unsigned* p)              { return __hip_atomic_load(p, __ATOMIC_RELAXED, __HIP_MEMORY_SCOPE_AGENT); }
__device__ __forceinline__ unsigned xb_add(unsigned* p, unsigned v) { return __hip_atomic_fetch_add(p, v, __ATOMIC_RELAXED, __HIP_MEMORY_SCOPE_AGENT); }
__device__ __forceinline__ unsigned xb_xcc_id() { return (unsigned)__builtin_amdgcn_s_getreg((3 << 11) | 20) & 0xFu; }
#define XB_SPIN(cond, bar) do { unsigned _sp = 0; while (cond) { __builtin_amdgcn_s_sleep(1); \
    if ((++_sp & 255u) == 0u) { if (xb_ld(&(bar)[XB_TMO])) break; if (_sp > XB_SPIN_CAP) { atomicAdd(&(bar)[XB_TMO], 1u); break; } } } } while (0)
struct XcdBarrier { unsigned* bar; unsigned x; volatile LAS unsigned* st; };
__device__ __forceinline__ XcdBarrier xcd_barrier_post(unsigned* bar, volatile LAS unsigned* st) {
    XcdBarrier b; b.bar = bar; b.x = xb_xcc_id(); b.st = st;
    if (threadIdx.x == 0) (void)xb_add(&bar[XB_XCNT(b.x)], 1u);
    return b;
}
__device__ __forceinline__ void xcd_barrier_complete(unsigned* bar, unsigned x, unsigned& nloc, unsigned& nx) {
    const unsigned G = gridDim.x * gridDim.y * gridDim.z;
    unsigned sum, cnt, mine, sp = 0u;
    for (;;) {
        sum = 0u; cnt = 0u; mine = 0u;
#pragma unroll
        for (unsigned j = 0; j < 16; ++j) { const unsigned c = xb_ld(&bar[XB_XCNT(j)]); sum += c; cnt += (c > 0u) ? 1u : 0u; mine = (j == x) ? c : mine; }
        if (sum == G) break;
        __builtin_amdgcn_s_sleep(1);
        if ((++sp & 255u) == 0u) { if (xb_ld(&bar[XB_TMO])) break; if (sp > XB_SPIN_CAP) { atomicAdd(&bar[XB_TMO], 1u); break; } }
    }
    nloc = mine > 0u ? mine : 1u; nx = cnt > 0u ? cnt : 1u;
}
__device__ __forceinline__ void xcd_barrier(const XcdBarrier& b) {
    asm volatile("s_waitcnt vmcnt(0)" ::: "memory");
    __syncthreads();
    if (threadIdx.x == 0) {
        unsigned* bar = b.bar;
        __builtin_amdgcn_s_waitcnt(0);
        unsigned nloc = b.st[0], nx = b.st[1];
        if (nloc == 0u) { xcd_barrier_complete(bar, b.x, nloc, nx); b.st[0] = nloc; b.st[1] = nx; }
        const unsigned old = xb_add(&bar[XB_XSUB(b.x)], 1u);
        const unsigned gen = old / nloc;
        if (old + 1u == (gen + 1u) * nloc) {
            __builtin_amdgcn_fence(__ATOMIC_RELEASE, "agent");
            asm volatile("s_waitcnt vmcnt(0)" ::: "memory");
            const unsigned og = xb_add(&bar[XB_TOP], 1u);
            const unsigned tg = og / nx;
            if (og + 1u == (tg + 1u) * nx) xb_add(&bar[XB_TOPGEN], 1u);
            else XB_SPIN(xb_ld(&bar[XB_TOPGEN]) == tg, bar);
            __builtin_amdgcn_fence(__ATOMIC_ACQUIRE, "agent");
            xb_add(&bar[XB_XGEN(b.x)], 1u);
            asm volatile("s_waitcnt vmcnt(0)" ::: "memory");
        } else {
            XB_SPIN(xb_ld(&bar[XB_XGEN(b.x)]) == gen, bar);
            __builtin_amdgcn_fence(__ATOMIC_ACQUIRE, "agent");
            asm volatile("s_waitcnt vmcnt(0)" ::: "memory");
        }
    }
    __syncthreads();
}

struct Args { const float* in[24]; float* out; unsigned char* ws; int ph_lo, ph_hi; };
enum { I_X = 0, I_C, I_WMOD, I_BMOD, I_WIN, I_BF, I_WCONV, I_QG, I_KVG, I_WUQ, I_WUKV, I_HG, I_WO, I_LN1G, I_LN1B, I_LN2G, I_LN2B, I_FWG, I_FWU, I_FWD, I_RW, I_EWG, I_EWU, I_EWD };

struct Ctx {
    LAS unsigned char* lds; volatile LAS unsigned* MISC; volatile LAS int* TAB;
    unsigned* ctl; unsigned char* ws; const float* const* in; float* out;
    int tid, lane, wave, vcu;
};

__device__ __forceinline__ void transpose_item(const Ctx& F, const float* W, int Nsrc, int srccol, int k0, const float* kscale, bf16* dst, int dstK, int n0) {
    LAS float* s = (LAS float*)(F.lds + F.wave * 16640);
    const float mask = srccol >= 0 ? 1.f : 0.f; const int sc = srccol >= 0 ? srccol : 0;
    const float* src = W + (size_t)k0 * Nsrc + sc;
    float v[64];
#pragma unroll
    for (int kk = 0; kk < 64; ++kk) v[kk] = src[(size_t)kk * Nsrc];
#pragma unroll
    for (int kk = 0; kk < 64; ++kk) s[kk * 65 + F.lane] = v[kk] * mask;
    LDS_WAIT(); asm volatile("" ::: "memory");
    const int c = F.lane >> 3, nl = F.lane & 7;
    f32x4 ks0 = {1.f, 1.f, 1.f, 1.f}, ks1 = {1.f, 1.f, 1.f, 1.f};
    if (kscale) { ks0 = *(const f32x4*)(kscale + k0 + 8 * c); ks1 = *(const f32x4*)(kscale + k0 + 8 * c + 4); }
#pragma unroll
    for (int j = 0; j < 8; ++j) {
        const int n = nl + 8 * j; const LAS float* p = s + (8 * c) * 65 + n;
        u32x4 o; o.x = pk2(p[0] * ks0[0], p[65] * ks0[1]); o.y = pk2(p[130] * ks0[2], p[195] * ks0[3]); o.z = pk2(p[260] * ks1[0], p[325] * ks1[1]); o.w = pk2(p[390] * ks1[2], p[455] * ks1[3]);
        *(u32x4*)(dst + (size_t)(n0 + n) * dstK + k0 + 8 * c) = o;
    }
    LDS_WAIT(); asm volatile("" ::: "memory");
}

__device__ __forceinline__ void p0_item(const Ctx& F, int it) {
    const float* const* in = F.in;
        if (it < 1984) {
            const int l = it / 992; int r = it % 992;
            if (r < 640) {
                const int kb = r / 40, nb = r % 40, np = nb * 64 + F.lane; int sc;
                if (np < 1152) sc = np; else if (np < 1184) { const int i = np - 1152; sc = 2438 + (i >> 1) + 16 * (i & 1); } else if (np < 1190) sc = 1152 + (np - 1184); else if (np < 1280) sc = -1; else sc = 1158 + (np - 1280);
                transpose_item(F, in[I_WIN] + (size_t)l * 1024 * INW, INW, sc, kb * 64, nullptr, (bf16*)(F.ws + R_WIN) + (size_t)l * INP * 1024, 1024, nb * 64);
            } else if (r < 688) {
                r -= 640; const int kb = r / 12, nb = r % 12, np = nb * 64 + F.lane; int sc = -1;
                if (np < 576) { const int hh = np / 96, j = np % 96; if (j < 64) sc = hh * 96 + j; else { const int i = j - 64; sc = hh * 96 + 64 + (i >> 1) + 16 * (i & 1); } }
                transpose_item(F, in[I_WUQ] + (size_t)l * 256 * 576, 576, sc, kb * 64, in[I_QG] + l * 256, (bf16*)(F.ws + R_WUQ) + (size_t)l * 768 * 256, 256, nb * 64);
            } else if (r < 736) {
                r -= 688; const int kb = r / 12, nb = r % 12;
                transpose_item(F, in[I_WUKV] + (size_t)l * 256 * 768, 768, nb * 64 + F.lane, kb * 64, in[I_KVG] + l * 256, (bf16*)(F.ws + R_WUKV) + (size_t)l * 768 * 256, 256, nb * 64);
            } else {
                r -= 736; const int kb = r / 16, nb = r % 16;
                transpose_item(F, in[I_WO] + (size_t)l * 1024 * 1024, 1024, nb * 64 + F.lane, kb * 64, in[I_HG] + l * 1024, (bf16*)(F.ws + R_WO) + (size_t)l * 1024 * 1024, 1024, nb * 64);
            }
        } else if (it < 3392) {
            const int r = it - 1984, kb = r / 88, nb = r % 88, n0 = nb * 64, pn = n0 >> 8, j0 = n0 & 255;
            const float* W = j0 < 128 ? in[I_FWG] : in[I_FWU];
            transpose_item(F, W, DFF, pn * 128 + (j0 & 127) + F.lane, kb * 64, nullptr, (bf16*)(F.ws + R_WGU), 1024, n0);
        } else if (it < 4096) {
            const int r = it - 3392, kb = r / 16, nb = r % 16;
            transpose_item(F, in[I_FWD], 1024, nb * 64 + F.lane, kb * 64, nullptr, (bf16*)(F.ws + R_WD), DFF, nb * 64);
        } else {
            int r = it - 4096; const int e = r / 2688; r %= 2688;
            if (r < 1792) {
                const int kb = r / 112, nb = r % 112, n0 = nb * 64, pn = n0 >> 8, j0 = n0 & 255;
                const float* W = (j0 < 128 ? in[I_EWG] : in[I_EWU]) + (size_t)e * 1024 * DEXP;
                transpose_item(F, W, DEXP, pn * 128 + (j0 & 127) + F.lane, kb * 64, nullptr, (bf16*)(F.ws + WS_WEGU) + (size_t)e * 7168 * 1024, 1024, n0);
            } else {
                r -= 1792; const int kb = r / 16, nb = r % 16;
                transpose_item(F, in[I_EWD] + (size_t)e * DEXP * 1024, 1024, nb * 64 + F.lane, kb * 64, nullptr, (bf16*)(F.ws + WS_WED) + (size_t)e * 1024 * DEXP, DEXP, nb * 64);
            }
        }
}

__device__ __forceinline__ void p0a(const Ctx& F) {
    const float* const* in = F.in;
    if ((int)blockIdx.x < 192) {
        const int kq = blockIdx.x / 48, l = (blockIdx.x % 48) / 24, col0 = (blockIdx.x % 24) * 256;
        const float* c = in[I_C]; const float* wm = in[I_WMOD] + (size_t)l * 1024 * 6144;
        const int kb = kq * 256 + F.wave * 32;
        float sc[4];
#pragma unroll
        for (int b = 0; b < 4; ++b) { const float v = c[b * 1024 + kb + (F.lane & 31)]; sc[b] = v / (1.f + __expf(-v)); }
        f32x4 acc[4];
#pragma unroll
        for (int b = 0; b < 4; ++b) acc[b] = (f32x4){0.f, 0.f, 0.f, 0.f};
        f32x4 w4[32];
#pragma unroll
        for (int kk = 0; kk < 32; ++kk) w4[kk] = *(const f32x4*)(wm + (size_t)(kb + kk) * 6144 + col0 + 4 * F.lane);
#pragma unroll
        for (int kk = 0; kk < 32; ++kk)
#pragma unroll
            for (int b = 0; b < 4; ++b) { const float sv = lane_get(sc[b], kk); acc[b] += w4[kk] * sv; }
        LAS float* red = (LAS float*)F.lds;
#pragma unroll
        for (int b = 0; b < 4; ++b) *(LAS f32x4*)(red + (F.wave * 4 + b) * 256 + 4 * F.lane) = acc[b];
        __syncthreads();
        float* MODP = (float*)(F.ws + WS_MOD) + (size_t)kq * 2 * 4 * 6144;
        for (int idx = F.tid; idx < 1024; idx += 512) {
            const int b = idx >> 8, col = idx & 255; float s = kq == 0 ? in[I_BMOD][l * 6144 + col0 + col] : 0.f;
#pragma unroll
            for (int w = 0; w < 8; ++w) s += red[(w * 4 + b) * 256 + col];
            MODP[(size_t)(l * 4 + b) * 6144 + col0 + col] = s;
        }
        __syncthreads();
    }
    {
        const int idx = blockIdx.x * 512 + F.tid;
        if (idx < SEQ * 16) {
            const int pos = idx >> 4, i = idx & 15;
            double inv = 1.0; for (int j = 0; j < i; ++j) inv *= 0.56234132519034908039;
            const double ang = (double)pos * inv;
            const double TWO_PI_HI = 6.283185307179586232, TWO_PI_LO = 2.4492935982947064e-16;
            const double n = __builtin_rint(ang * 0.15915494309189533577);
            double r = __builtin_fma(-n, TWO_PI_HI, ang); r = __builtin_fma(-n, TWO_PI_LO, r);
            const double r2 = r * r; double sn = r, cs = 1.0, ts = r, tc = 1.0;
            for (int k = 1; k <= 14; ++k) { tc = -tc * r2 / (double)((2 * k - 1) * (2 * k)); cs += tc; ts = -ts * r2 / (double)((2 * k) * (2 * k + 1)); sn += ts; }
            ((f32x2*)(F.ws + WS_CS))[idx] = (f32x2){(float)cs, (float)sn};
        }
    }
    const int gw = F.vcu * NWAVES + F.wave, NGW = NBLK * NWAVES;
    for (int it = gw; it < (EXPERT_SLOTS ? 4096 : 25600); it += NGW) p0_item(F, it);
}

__device__ __forceinline__ void convert_experts(const Ctx& F, int slot) {
    if (!EXPERT_SLOTS || (int)blockIdx.x < 128) return;
    const int lw = ((int)blockIdx.x - 128) * NWAVES + F.wave;
    for (int i = 0; i < 7; ++i) p0_item(F, 4096 + slot * 7168 + lw + 1024 * i);
}

template <int MODE, bool MOE, bool WRITE_H>
__device__ __forceinline__ void row_phase(const Ctx& F, int l) {
    const float* MOD = (const float*)(F.ws + WS_MOD);
    const float* Y = (const float*)(F.ws + R_Y);
    float* RA = (float*)(F.ws + WS_RA);
    bf16* H = (bf16*)(F.ws + WS_H);
    volatile LAS int* lcnt = (volatile LAS int*)(F.lds);
    LAS int* rec = (LAS int*)(F.lds + 256);
    LAS float* recw = (LAS float*)(F.lds + 256 + 1024);
    LAS float* vec = (LAS float*)(F.lds + 4096);
    const int rowb = blockIdx.x * 64, b = rowb >> 12, lane = F.lane;
    const float* modb = MOD + (size_t)(l * 4 + b) * 6144;
    {
        const float* gate = modb + (MODE == 1 ? 2 : 5) * 1024;
        const float* lg = F.in[MODE == 1 ? I_LN1G : I_LN2G] + l * 1024; const float* lb = F.in[MODE == 1 ? I_LN1B : I_LN2B] + l * 1024;
        const float* modn = MODE == 0 ? modb : (MODE == 1 ? modb + 3 * 1024 : MOD + (size_t)((l + 1) * 4 + b) * 6144);
        constexpr size_t PQ = (size_t)2 * 4 * 6144;
        for (int i = F.tid; i < 1024; i += 512) {
            if (MODE != 0) { vec[i] = (gate[i] + gate[PQ + i]) + (gate[2 * PQ + i] + gate[3 * PQ + i]); vec[1024 + i] = lg[i]; vec[2048 + i] = lb[i]; }
            if (WRITE_H) { vec[3072 + i] = (modn[1024 + i] + modn[PQ + 1024 + i]) + (modn[2 * PQ + 1024 + i] + modn[3 * PQ + 1024 + i]); vec[4096 + i] = (modn[i] + modn[PQ + i]) + (modn[2 * PQ + i] + modn[3 * PQ + i]); }
        }
        if (MODE == 1 && MOE) { if (F.tid < 16) lcnt[F.tid] = 0; }
        __syncthreads();
    }
    int start[8];
    if (MODE == 2 && MOE) { int s = 0;
#pragma unroll
        for (int e = 0; e < 8; ++e) { start[e] = s; s += (int)__hip_atomic_load(F.ctl + CW_CNT + 64 * e, RLX_AGENT); } }
    const float* res = MODE == 0 ? F.in[I_X] : (MODE == 1 ? (l == 0 ? F.in[I_X] : F.out) : RA);
    float* xo = MODE == 1 ? RA : F.out;
    for (int rr = 0; rr < 4; ++rr) {
        f32x4 v[2][4];
        f32x4 ym[2][4];
        if (MODE == 2 && MOE) {
            const bf16* YR = (const bf16*)(F.ws + WS_WEGU);
#pragma unroll
            for (int q = 0; q < 2; ++q) { const int row = rowb + F.wave * 8 + rr + 4 * q;
                const int p0 = ((const int*)(F.ws + WS_TOKP))[row * 2], p1 = ((const int*)(F.ws + WS_TOKP))[row * 2 + 1];
                const float w0 = ((const float*)(F.ws + WS_TOKW))[row * 2], w1 = ((const float*)(F.ws + WS_TOKW))[row * 2 + 1];
                int s0 = 0, s1 = 0;
#pragma unroll
                for (int e = 0; e < 8; ++e) { if ((p0 >> 14) == e) s0 = start[e]; if ((p1 >> 14) == e) s1 = start[e]; }
                const size_t r0 = (size_t)(s0 + (p0 & 16383)), r1 = (size_t)(s1 + (p1 & 16383));
#pragma unroll
                for (int j = 0; j < 4; ++j) { const int c = 4 * lane + 256 * j; const u32x2 a = *(const u32x2*)(YR + r0 * 1024 + c), bq = *(const u32x2*)(YR + r1 * 1024 + c);
                    ym[q][j] = (f32x4){bflo(a.x), bfhi(a.x), bflo(a.y), bfhi(a.y)} * w0 + (f32x4){bflo(bq.x), bfhi(bq.x), bflo(bq.y), bfhi(bq.y)} * w1; } }
        }
#pragma unroll
        for (int q = 0; q < 2; ++q) {
            const int row = rowb + F.wave * 8 + rr + 4 * q;
            if (MODE == 0) {
#pragma unroll
                for (int j = 0; j < 4; ++j) v[q][j] = *(const f32x4*)(res + (size_t)row * 1024 + 4 * lane + 256 * j);
            } else {
                f32x4 y[4];
                if (MODE == 2 && MOE) {
#pragma unroll
                    for (int j = 0; j < 4; ++j) y[j] = ym[q][j];
                } else {
#pragma unroll
                    for (int j = 0; j < 4; ++j) y[j] = *(const f32x4*)(Y + (size_t)row * 1024 + 4 * lane + 256 * j);
                }
#pragma unroll
                for (int j = 0; j < 4; ++j) { const int c = 4 * lane + 256 * j; const f32x4 r4 = *(const f32x4*)(res + (size_t)row * 1024 + c), g4 = *(const LAS f32x4*)(vec + c);
                    v[q][j] = r4 * ALPHA + (g4 + 1.f) * y[j]; }
            }
        }
        if (MODE != 0) {
            float s[2], qq[2];
#pragma unroll
            for (int q = 0; q < 2; ++q) { s[q] = 0.f;
#pragma unroll
                for (int j = 0; j < 4; ++j) s[q] += (v[q][j][0] + v[q][j][1]) + (v[q][j][2] + v[q][j][3]); }
#pragma unroll
            for (int o = 1; o < 64; o <<= 1) { s[0] += lane_xor(s[0], lane, o); s[1] += lane_xor(s[1], lane, o); }
#pragma unroll
            for (int q = 0; q < 2; ++q) { const float mean = s[q] * (1.f / 1024.f); qq[q] = 0.f;
#pragma unroll
                for (int j = 0; j < 4; ++j) { v[q][j] = v[q][j] - mean; qq[q] += (v[q][j][0] * v[q][j][0] + v[q][j][1] * v[q][j][1]) + (v[q][j][2] * v[q][j][2] + v[q][j][3] * v[q][j][3]); } }
#pragma unroll
            for (int o = 1; o < 64; o <<= 1) { qq[0] += lane_xor(qq[0], lane, o); qq[1] += lane_xor(qq[1], lane, o); }
#pragma unroll
            for (int q = 0; q < 2; ++q) {
                const int row = rowb + F.wave * 8 + rr + 4 * q;
                const float rstd = __builtin_amdgcn_rsqf(qq[q] * (1.f / 1024.f) + LN_EPS);
#pragma unroll
                for (int j = 0; j < 4; ++j) { const int c = 4 * lane + 256 * j; const f32x4 g4 = *(const LAS f32x4*)(vec + 1024 + c), b4 = *(const LAS f32x4*)(vec + 2048 + c);
                    v[q][j] = v[q][j] * rstd * g4 + b4; *(f32x4*)(xo + (size_t)row * 1024 + c) = v[q][j]; }
            }
        }
        if (WRITE_H) {
#pragma unroll
            for (int q = 0; q < 2; ++q) {
                const int row = rowb + F.wave * 8 + rr + 4 * q;
#pragma unroll
                for (int j = 0; j < 4; ++j) { const int c = 4 * lane + 256 * j; const f32x4 sc = *(const LAS f32x4*)(vec + 3072 + c), sh = *(const LAS f32x4*)(vec + 4096 + c);
                    v[q][j] = v[q][j] * (sc + 1.f) + sh;
                    u32x2 w; w.x = pk2(v[q][j][0], v[q][j][1]); w.y = pk2(v[q][j][2], v[q][j][3]); *(u32x2*)(H + (size_t)row * 1024 + c) = w; }
            }
        }
        if (MODE == 1 && MOE) {
            const float* rw = F.in[I_RW];
#pragma unroll
            for (int q = 0; q < 2; ++q) {
                const int rl = F.wave * 8 + rr + 4 * q;
                float lg8[8];
#pragma unroll
                for (int e = 0; e < 8; ++e) lg8[e] = 0.f;
#pragma unroll
                for (int j = 0; j < 4; ++j)
#pragma unroll
                    for (int i = 0; i < 4; ++i) { const int c = 4 * lane + 256 * j + i; const f32x4 wa = *(const f32x4*)(rw + (size_t)c * 8), wb = *(const f32x4*)(rw + (size_t)c * 8 + 4); const float hv = v[q][j][i];
                        lg8[0] += hv * wa[0]; lg8[1] += hv * wa[1]; lg8[2] += hv * wa[2]; lg8[3] += hv * wa[3]; lg8[4] += hv * wb[0]; lg8[5] += hv * wb[1]; lg8[6] += hv * wb[2]; lg8[7] += hv * wb[3]; }
#pragma unroll
                for (int o = 1; o < 64; o <<= 1)
#pragma unroll
                    for (int e = 0; e < 8; ++e) lg8[e] += lane_xor(lg8[e], lane, o);
                int e0 = 0; float m0 = lg8[0];
#pragma unroll
                for (int e = 1; e < 8; ++e) if (lg8[e] > m0) { m0 = lg8[e]; e0 = e; }
                int e1 = -1; float m1 = -INFINITY;
#pragma unroll
                for (int e = 0; e < 8; ++e) if (e != e0 && lg8[e] > m1) { m1 = lg8[e]; e1 = e; }
                if (lane == 0) {
                    const float ex = __expf(m1 - m0), w0 = 1.f / (1.f + ex), w1 = ex / (1.f + ex);
                    const int k0 = __hip_atomic_fetch_add((LAS int*)(F.lds) + e0, 1, __ATOMIC_RELAXED, __HIP_MEMORY_SCOPE_WORKGROUP);
                    const int k1 = __hip_atomic_fetch_add((LAS int*)(F.lds) + e1, 1, __ATOMIC_RELAXED, __HIP_MEMORY_SCOPE_WORKGROUP);
                    rec[rl * 4 + 0] = e0; rec[rl * 4 + 1] = e1; rec[rl * 4 + 2] = k0; rec[rl * 4 + 3] = k1; recw[rl * 2] = w0; recw[rl * 2 + 1] = w1;
                }
            }
        }
    }
    if (MODE == 1 && MOE) {
        __syncthreads();
        if (F.tid < 8) lcnt[8 + F.tid] = (int)__hip_atomic_fetch_add(F.ctl + CW_CNT + 64 * F.tid, (unsigned)lcnt[F.tid], RLX_AGENT);
        __syncthreads();
        if (F.tid < 128) {
            const int rl = F.tid >> 1, k = F.tid & 1, e = rec[rl * 4 + k], pos = lcnt[8 + e] + rec[rl * 4 + 2 + k], row = rowb + rl;
            ((int*)(F.ws + WS_ROWL))[e * 16384 + pos] = row;
            ((int*)(F.ws + WS_TOKP))[row * 2 + k] = e * 16384 + pos;
            ((float*)(F.ws + WS_TOKW))[row * 2 + k] = recw[rl * 2 + k];
        }
    }
    __syncthreads();
}

__device__ __forceinline__ void scan_conv(const Ctx& F, int l) {
    const int gw = F.vcu * NWAVES + F.wave, lane = F.lane;
    if (gw >= 2048 - 24) {
        const int bh = gw - (2048 - 24), b = bh / 6, h = bh % 6; const float* LOGF = (const float*)(F.ws + WS_LOGF); float* G = (float*)(F.ws + WS_G) + (size_t)bh * SEQ;
        float v[64];
#pragma unroll
        for (int j = 0; j < 64; ++j) v[j] = LOGF[(size_t)(b * SEQ + j * 64 + lane) * 8 + h];
#pragma unroll
        for (int o = 1; o < 64; o <<= 1) {
#pragma unroll
            for (int j = 0; j < 64; ++j) { const float t = lane_get(v[j], lane - o); if (lane >= o) v[j] += t; }
        }
        float carry = 0.f;
#pragma unroll
        for (int j = 0; j < 64; ++j) { const float tot = __int_as_float(__builtin_amdgcn_readlane(__float_as_int(v[j]), 63)); v[j] += carry; carry += tot; G[j * 64 + lane] = -v[j] * LOG2E; }
    }
    const bf16* C3 = (const bf16*)(F.ws + R_CONV3); bf16* OM = (bf16*)(F.ws + R_OM);
    const float* wc = F.in[I_WCONV] + l * 3 * 256;
    const f32x4 w0 = *(const f32x4*)(wc + 4 * lane), w1 = *(const f32x4*)(wc + 256 + 4 * lane), w2 = *(const f32x4*)(wc + 512 + 4 * lane);
    const int m0 = gw * 8, t0 = m0 & (SEQ - 1);
    u32x2 cg[10], hn[10], bg[8];
#pragma unroll
    for (int i = 0; i < 10; ++i) { const int m = (t0 == 0 && i < 2) ? m0 : m0 - 2 + i; const bf16* rp = C3 + (size_t)m * 768 + 4 * lane; cg[i] = *(const u32x2*)(rp + 256); hn[i] = *(const u32x2*)(rp + 512); }
#pragma unroll
    for (int i = 0; i < 8; ++i) bg[i] = *(const u32x2*)(C3 + (size_t)(m0 + i) * 768 + 4 * lane);
    f32x4 u[10];
#pragma unroll
    for (int i = 0; i < 10; ++i) { u[i] = (f32x4){bflo(cg[i].x) * bflo(hn[i].x), bfhi(cg[i].x) * bfhi(hn[i].x), bflo(cg[i].y) * bflo(hn[i].y), bfhi(cg[i].y) * bfhi(hn[i].y)}; if (t0 == 0 && i < 2) u[i] = (f32x4){0.f, 0.f, 0.f, 0.f}; }
    float ss[8]; f32x4 o[8];
#pragma unroll
    for (int i = 0; i < 8; ++i) {
        const f32x4 cv = u[i] * w0 + u[i + 1] * w1 + u[i + 2] * w2;
        o[i] = cv * (f32x4){bflo(bg[i].x), bfhi(bg[i].x), bflo(bg[i].y), bfhi(bg[i].y)};
        ss[i] = (o[i][0] * o[i][0] + o[i][1] * o[i][1]) + (o[i][2] * o[i][2] + o[i][3] * o[i][3]);
    }
#pragma unroll
    for (int x = 1; x < 16; x <<= 1)
#pragma unroll
        for (int i = 0; i < 8; ++i) ss[i] += lane_xor(ss[i], lane, x);
#pragma unroll
    for (int i = 0; i < 8; ++i) {
        const float rstd = __builtin_amdgcn_rsqf(ss[i] * (1.f / 64.f) + RMS_EPS);
        const f32x4 r = o[i] * rstd; u32x2 w; w.x = pk2(r[0], r[1]); w.y = pk2(r[2], r[3]);
        *(u32x2*)(OM + (size_t)(m0 + i) * 1024 + 384 + 4 * lane) = w;
    }
}

namespace att {
typedef short v4i16_t __attribute__((ext_vector_type(4)));
constexpr int KB0 = 0, KBSZ = 12288, VB0 = 2 * KBSZ, VBSZ = 8192, GB0 = VB0 + 2 * VBSZ;
static_assert(GB0 + 512 <= RING_BYTES, "attention LDS");
__device__ __forceinline__ int crow(int r, int hi) { return (r & 3) + 8 * (r >> 2) + 4 * hi; }
__device__ __forceinline__ s16x4 vtr(const LAS unsigned char* p) { return __builtin_bit_cast(s16x4, __builtin_amdgcn_ds_read_tr16_b64_v4i16((LAS v4i16_t*)p)); }

__device__ __forceinline__ float half_max(float x) { auto rr = __builtin_amdgcn_permlane32_swap(__float_as_uint(x), __float_as_uint(x), false, false); return fmaxf(__uint_as_float(rr[0]), __uint_as_float(rr[1])); }
__device__ __forceinline__ float half_sum(float x) { auto rr = __builtin_amdgcn_permlane32_swap(__float_as_uint(x), __float_as_uint(x), false, false); return __uint_as_float(rr[0]) + __uint_as_float(rr[1]); }

template <bool FOX>
__device__ __forceinline__ void unit(const Ctx& F, int b, int h, int qb) {
    constexpr int ND = FOX ? 4 : 6;
    const int lane = F.lane, wid = F.wave, r32 = lane & 31, hi = lane >> 5;
    const size_t rowbase = (size_t)b * SEQ; const int q0 = qb * 256;
    const bf16 *Qp, *Kp, *Vp; int qpitch, kpitch;
    if (FOX) { Qp = (const bf16*)(F.ws + R_FQ) + rowbase * 384 + h * 64; Kp = (const bf16*)(F.ws + R_FK) + rowbase * 384 + h * 64; Vp = (const bf16*)(F.ws + R_FV) + rowbase * 384 + h * 64; qpitch = 384; kpitch = 384; }
    else { Qp = (const bf16*)(F.ws + R_QM) + rowbase * 576 + h * 96; Kp = (const bf16*)(F.ws + R_KVM) + rowbase * 768 + h * 128; Vp = Kp + 64; qpitch = 576; kpitch = 768; }
    const bf16* KRp = (const bf16*)(F.ws + R_KR) + rowbase * 32;
    const float* Gp = (const float*)(F.ws + WS_G) + (size_t)(b * 6 + h) * SEQ;
    LAS unsigned char* lds = F.lds;
    const int NT = (q0 + 256) / 64;
    bf16x8 qr[ND];
    { const bf16* Qw = Qp + (size_t)(q0 + wid * 32 + r32) * qpitch + hi * 8;
#pragma unroll
      for (int d0 = 0; d0 < ND; ++d0) qr[d0] = *(const bf16x8*)(Qw + d0 * 16); }
    u32x4 kreg0, kreg1 = {0u, 0u, 0u, 0u}, vreg; float greg = 0.f;
    const bf16* ksrc = Kp + (size_t)lane * kpitch + wid * 8;
    const bf16* krsrc = KRp + (size_t)lane * 32 + (wid & 3) * 8;
    const bf16* vsrc = Vp + (size_t)(16 * (wid & 3) + (lane >> 2)) * kpitch + (wid >> 2) * 32 + (lane & 3) * 8;
#define ATT_LOADK(t) do { kreg0 = *(const u32x4*)(ksrc + (size_t)(t) * 64 * kpitch); if (!FOX && wid < 4) kreg1 = *(const u32x4*)(krsrc + (size_t)(t) * 64 * 32); if (FOX && wid == 0) greg = Gp[(t) * 64 + lane]; } while (0)
#define ATT_LOADV(t) do { vreg = *(const u32x4*)(vsrc + (size_t)(t) * 64 * kpitch); } while (0)
#define ATT_STOREK(buf) do { *(LAS u32x4*)(lds + KB0 + (buf) * KBSZ + wid * 1024 + lane * 16) = kreg0; if (!FOX && wid < 4) *(LAS u32x4*)(lds + KB0 + (buf) * KBSZ + (8 + wid) * 1024 + lane * 16) = kreg1; \
        if (FOX && wid == 0) *(LAS float*)(lds + GB0 + (buf) * 256 + lane * 4) = greg; } while (0)
#define ATT_STOREV(buf) do { *(LAS u32x4*)(lds + VB0 + (buf) * VBSZ + wid * 1024 + lane * 16) = vreg; } while (0)
#define ATT_QK(a0, a1, buf) do { \
        if (FOX) { const LAS float* gb_ = (const LAS float*)(lds + GB0 + (buf) * 256); \
            _Pragma("unroll") for (int g_ = 0; g_ < 4; ++g_) { const f32x4 x_ = *(const LAS f32x4*)(gb_ + 8 * g_ + 4 * hi), y_ = *(const LAS f32x4*)(gb_ + 32 + 8 * g_ + 4 * hi); \
                _Pragma("unroll") for (int j_ = 0; j_ < 4; ++j_) { a0[4 * g_ + j_] = x_[j_]; a1[4 * g_ + j_] = y_[j_]; } } } \
        else { a0 = f32x16{}; a1 = f32x16{}; } \
        const LAS unsigned char* kb_ = lds + KB0 + (buf) * KBSZ + hi * 1024 + r32 * 16; \
        bf16x8 kf_[2 * ND]; \
        _Pragma("unroll") for (int d0 = 0; d0 < ND; ++d0) { kf_[2 * d0] = *(const LAS bf16x8*)(kb_ + d0 * 2048); kf_[2 * d0 + 1] = *(const LAS bf16x8*)(kb_ + d0 * 2048 + 512); } \
        __builtin_amdgcn_sched_barrier(0);        \
        _Pragma("unroll") for (int d0 = 0; d0 < ND; ++d0) { \
            a0 = __builtin_amdgcn_mfma_f32_32x32x16_bf16(kf_[2 * d0], qr[d0], a0, 0, 0, 0); a1 = __builtin_amdgcn_mfma_f32_32x32x16_bf16(kf_[2 * d0 + 1], qr[d0], a1, 0, 0, 0); } \
        __builtin_amdgcn_sched_barrier(0); } while (0)
    f32x16 o[2]; o[0] = f32x16{}; o[1] = f32x16{};
    float m_run = -INFINITY, l_run = 0.f;
    const int qmin = q0 + wid * 32, qabs = qmin + r32;
    ATT_LOADK(0); ATT_LOADV(0); ATT_STOREK(0); ATT_STOREV(0);
    ATT_LOADK(1); ATT_STOREK(1);
    __syncthreads();
    f32x16 p0, p1, n0 = f32x16{}, n1 = f32x16{};
    ATT_QK(p0, p1, 0);
    for (int t = 0; t < NT; ++t) {
        const int buf = t & 1;
        const bool act = (64 * t <= qmin + 31), actn = (t + 1 < NT) && (64 * (t + 1) <= qmin + 31);
        if (t + 2 < NT) ATT_LOADK(t + 2);
        if (t + 1 < NT) ATT_LOADV(t + 1);
        if (actn) ATT_QK(n0, n1, buf ^ 1);
        if (act) {
            if (64 * t + 63 > qmin) {
#pragma unroll
                for (int r = 0; r < 16; ++r) { const int kv = 64 * t + crow(r, hi); if (kv > qabs) p0[r] = -INFINITY; if (kv + 32 > qabs) p1[r] = -INFINITY; }
            }
            float mx = fmaxf(p0[0], p1[0]);
#pragma unroll
            for (int r = 1; r < 16; ++r) mx = fmaxf(fmaxf(mx, p0[r]), p1[r]);
            mx = half_max(mx);
            const float m_new = fmaxf(m_run, mx);
            const float alpha = __builtin_amdgcn_exp2f(m_run - m_new);
            m_run = m_new;
            float ls = 0.f;
#pragma unroll
            for (int r = 0; r < 16; ++r) { p0[r] = __builtin_amdgcn_exp2f(p0[r] - m_new); p1[r] = __builtin_amdgcn_exp2f(p1[r] - m_new); ls += p0[r] + p1[r]; }
            l_run = l_run * alpha + ls;
            if (__builtin_amdgcn_ballot_w64(alpha != 1.f) != 0ull) {
#pragma unroll
                for (int r = 0; r < 16; ++r) { o[0][r] *= alpha; o[1][r] *= alpha; }
            }
            u32x4 pw[4];
#pragma unroll
            for (int s = 0; s < 2; ++s) {
                pw[s] = (u32x4){pk2(p0[8 * s], p0[8 * s + 1]), pk2(p0[8 * s + 2], p0[8 * s + 3]), pk2(p0[8 * s + 4], p0[8 * s + 5]), pk2(p0[8 * s + 6], p0[8 * s + 7])};
                pw[2 + s] = (u32x4){pk2(p1[8 * s], p1[8 * s + 1]), pk2(p1[8 * s + 2], p1[8 * s + 3]), pk2(p1[8 * s + 4], p1[8 * s + 5]), pk2(p1[8 * s + 6], p1[8 * s + 7])};
            }
            const LAS unsigned char* vb = lds + VB0 + buf * VBSZ + ((lane >> 4) & 1) * 32 + (lane & 3) * 8 + (4 * hi + ((lane & 15) >> 2)) * 64;
            s16x4 vlo[8], vhi[8];
#pragma unroll
            for (int ks = 0; ks < 4; ++ks)
#pragma unroll
                for (int d0 = 0; d0 < 2; ++d0) { vlo[2 * ks + d0] = vtr(vb + d0 * 4096 + ks * 1024); vhi[2 * ks + d0] = vtr(vb + d0 * 4096 + ks * 1024 + 512); }
            __builtin_amdgcn_sched_barrier(0);
#pragma unroll
            for (int ks = 0; ks < 4; ++ks)
#pragma unroll
                for (int d0 = 0; d0 < 2; ++d0) {
                    const s16x4 lo = vlo[2 * ks + d0], hh = vhi[2 * ks + d0];
                    const bf16x8 vf = (bf16x8){lo[0], lo[1], lo[2], lo[3], hh[0], hh[1], hh[2], hh[3]};
                    o[d0] = __builtin_amdgcn_mfma_f32_32x32x16_bf16(vf, __builtin_bit_cast(bf16x8, pw[ks]), o[d0], 0, 0, 0);
                }
            __builtin_amdgcn_sched_barrier(0);
        }
        if (t + 2 < NT) ATT_STOREK(buf);
        if (t + 1 < NT) ATT_STOREV(buf ^ 1);
        __syncthreads();
        p0 = n0; p1 = n1;
    }
#undef ATT_LOADK
#undef ATT_LOADV
#undef ATT_STOREK
#undef ATT_STOREV
#undef ATT_QK
    const float inv = 1.0f / half_sum(l_run);
    float ss = 0.f;
#pragma unroll
    for (int r = 0; r < 16; ++r) { o[0][r] *= inv; o[1][r] *= inv; ss += o[0][r] * o[0][r] + o[1][r] * o[1][r]; }
    ss = half_sum(ss);
    const float rstd = __builtin_amdgcn_rsqf(ss * (1.f / 64.f) + RMS_EPS);
    bf16* OMr = (bf16*)(F.ws + R_OM) + (rowbase + q0 + wid * 32 + r32) * 1024 + (FOX ? h * 64 : 640 + h * 64) + 4 * hi;
#pragma unroll
    for (int d0 = 0; d0 < 2; ++d0)
#pragma unroll
        for (int g = 0; g < 4; ++g) {
            u32x2 w; w.x = pk2(o[d0][4 * g] * rstd, o[d0][4 * g + 1] * rstd); w.y = pk2(o[d0][4 * g + 2] * rstd, o[d0][4 * g + 3] * rstd);
            *(u32x2*)(OMr + 32 * d0 + 8 * g) = w;
        }
}

__device__ __forceinline__ void phase(const Ctx& F, int l) {
    unsigned* ctr = F.ctl + CW_AQ + 64 * l;
    for (;;) {
        if (F.tid == 0) F.MISC[4] = __hip_atomic_fetch_add(ctr, 1u, RLX_AGENT);
        __syncthreads();
        const int u = (int)F.MISC[4];
        __syncthreads();
        if (u >= 768) break;
        const int qb = 15 - u / 48, rem = u % 48, type = rem / 24, bh = rem % 24, b = bh / 6, h = bh % 6;
        if (type == 0) unit<false>(F, b, h, qb); else unit<true>(F, b, h, qb);
    }
}
}

__device__ __forceinline__ void moe_tables(const Ctx& F, int nN) {
    if (F.tid == 0) { int s = 0, up = 0;
        for (int e = 0; e < 8; ++e) { const int c = (int)__hip_atomic_load(F.ctl + CW_CNT + 64 * e, RLX_AGENT), nM = (c + 255) >> 8; F.TAB[e] = c; F.TAB[8 + e] = s; F.TAB[16 + e] = up; F.TAB[25 + e] = nM; s += c; up += nM * nN; }
        F.TAB[24] = up;
        const int full = (up >> 8) << 8, tl = up - full, sk = tl == 0 ? 1 : (tl <= 18 ? 14 : (tl <= 36 ? 7 : (tl <= 64 ? 4 : (tl <= 128 ? 2 : 1))));
        F.TAB[33] = full; F.TAB[34] = tl * sk; F.TAB[35] = sk; }
    __syncthreads();
}

__device__ __forceinline__ void tail_reduce(const Ctx& F) {
    moe_tables(F, 4);
    const int full = F.TAB[33], nsub = F.TAB[34], SK = F.TAB[35], TL = nsub / SK;
    const bf16* SL = (const bf16*)(F.ws + WS_H); bf16* YR = (bf16*)(F.ws + WS_WEGU);
    for (int g = (int)blockIdx.x * 512 + F.tid; g < TL * 16384; g += NBLK * 512) {
        const int i = g >> 14, idx = g & 16383, r = idx >> 6, c4 = (idx & 63) * 4, wgid = full + i;
        int e = 0;
#pragma unroll
        for (int j = 1; j < 8; ++j) if (wgid >= F.TAB[16 + j]) e = j;
        int pm, pn; g8::grouped_pmpn(wgid - F.TAB[16 + e], F.TAB[25 + e], 4, pm, pn);
        const bf16* sp = SL + (size_t)i * SK * 65536 + r * 256 + c4;
        u32x2 pa[14];
#pragma unroll
        for (int s = 0; s < 14; ++s) pa[s] = *(const u32x2*)(sp + (size_t)(s < SK ? s : 0) * 65536);
        f32x4 val = {0.f, 0.f, 0.f, 0.f};
#pragma unroll
        for (int s = 0; s < 14; ++s) { const float mk = s < SK ? 1.f : 0.f; val += (f32x4){bflo(pa[s].x), bfhi(pa[s].x), bflo(pa[s].y), bfhi(pa[s].y)} * mk; }
        if (pm * 256 + r < F.TAB[e]) { u32x2 w; w.x = pk2(val[0], val[1]); w.y = pk2(val[2], val[3]); *(u32x2*)(YR + (size_t)(F.TAB[8 + e] + pm * 256 + r) * 1024 + pn * 256 + c4) = w; }
    }
}

__global__ void __launch_bounds__(NWAVES * 64, 2) mk_fwd(Args args) {
    extern __shared__ __attribute__((aligned(16))) unsigned char lds_raw[];
    Ctx F;
    F.lds = (LAS unsigned char*)lds_raw; F.MISC = (volatile LAS unsigned*)(F.lds + MISC_OFF); F.TAB = (volatile LAS int*)(F.lds + TAB_OFF);
    F.tid = threadIdx.x; F.lane = F.tid & 63; F.wave = __builtin_amdgcn_readfirstlane(F.tid >> 6);
    { const int bx = blockIdx.x; F.vcu = (bx % 8) * (NBLK / 8) + bx / 8; }
    F.ws = args.ws; F.ctl = (unsigned*)(args.ws + WS_CTL); F.in = args.in; F.out = args.out;
    for (int u = F.tid; u < (LDS_BYTES - SCR_BYTES) / 4; u += NWAVES * 64) ((LAS unsigned*)(F.lds + SCR_BYTES))[u] = 0u;
    __syncthreads();
    const int lo = args.ph_lo, hi = args.ph_hi;
    XcdBarrier bar; bar.bar = F.ctl + CW_BAR; bar.x = 0; bar.st = nullptr;
    if (hi - lo > 1) bar = xcd_barrier_post(F.ctl + CW_BAR, F.MISC + 8);
    const int G = NBLK, cb = (int)blockIdx.x;

    for (int ph = lo; ph < hi; ++ph) {
        { int t_ = threadIdx.x; asm volatile("" : "+v"(t_)); F.tid = t_; F.lane = t_ & 63; F.wave = __builtin_amdgcn_readfirstlane(t_ >> 6); }
        const int nrep = ((REP_MASK >> ph) & 1) ? 2 : 1;
        for (int rep = 0; rep < nrep; ++rep) {
        if (ph == 0) { if (PHM(8)) p0a(F); }
        else if (ph == 1) { if (PHM(9)) row_phase<0, false, true>(F, 0); }
        else {
            const int l = ph < 10 ? 0 : 1; int s = ph < 10 ? ph - 2 : ph - 10; const bool moe = (l == 1);
            if (moe && s == 7) { tail_reduce(F); s = 99; } else if (moe && s == 8) s = 7;
            if (s == 0 && PHM(0)) {
                g8::SchedPlain S{(const char*)(F.ws + WS_H), (const char*)(F.ws + R_WIN) + (size_t)l * INP * 1024 * 2, T / 256, INP / 256, 1024, G, cb};
                g8::EpiIn E{(bf16*)(F.ws + R_FQ), (bf16*)(F.ws + R_FK), (bf16*)(F.ws + R_FV), (bf16*)(F.ws + R_KR), (bf16*)(F.ws + R_CONV3), (bf16*)(F.ws + R_CQ), (bf16*)(F.ws + R_CKV),
                            (float*)(F.ws + WS_LOGF), (float*)(F.ws + WS_SSQ), F.in[I_BF] + l * 6, (const f32x2*)(F.ws + WS_CS)};
                g8::gemm_phase<g8::EpiIn, g8::SchedPlain, false>(F.lds, F.tid, 1024, 1024, S, E);
                convert_experts(F, l == 0 ? 0 : 2);
            } else if (s == 1 && PHM(1)) {
#ifndef NO_SCANCONV
                scan_conv(F, l);
#endif
                { int t_ = threadIdx.x; asm volatile("" : "+v"(t_)); F.tid = t_; F.lane = t_ & 63; }
                { g8::SchedPlain S{(const char*)(F.ws + R_CQ), (const char*)(F.ws + R_WUQ) + (size_t)l * 768 * 256 * 2, T / 256, 3, 256, G, cb};
                  g8::EpiUp<0> E{(bf16*)(F.ws + R_QM), (bf16*)(F.ws + R_KVM), (const float*)(F.ws + WS_SSQ), (const f32x2*)(F.ws + WS_CS)};
                  g8::gemm_phase<g8::EpiUp<0>, g8::SchedPlain, false>(F.lds, F.tid, 256, 256, S, E); }
                { int t_ = threadIdx.x; asm volatile("" : "+v"(t_)); F.tid = t_; F.lane = t_ & 63; }
                { g8::SchedPlain S{(const char*)(F.ws + R_CKV), (const char*)(F.ws + R_WUKV) + (size_t)l * 768 * 256 * 2, T / 256, 3, 256, G, (cb + 128) & 255};
                  g8::EpiUp<1> E{(bf16*)(F.ws + R_QM), (bf16*)(F.ws + R_KVM), (const float*)(F.ws + WS_SSQ), (const f32x2*)(F.ws + WS_CS)};
                  g8::gemm_phase<g8::EpiUp<1>, g8::SchedPlain, false>(F.lds, F.tid, 256, 256, S, E); }
            } else if (s == 2 && PHM(2)) {
                att::phase(F, l + 2 * rep);
            } else if (s == 3 && PHM(3)) {
                g8::SchedPlain S{(const char*)(F.ws + R_OM), (const char*)(F.ws + R_WO) + (size_t)l * 1024 * 1024 * 2, T / 256, 4, 1024, G, cb};
                g8::EpiF32 E{(float*)(F.ws + R_Y), 1024};
                g8::gemm_phase<g8::EpiF32, g8::SchedPlain, false>(F.lds, F.tid, 1024, 1024, S, E);
            } else if (s == 4 && PHM(4)) {
                if (moe) row_phase<1, true, true>(F, l); else row_phase<1, false, true>(F, l);
            } else if (s == 5) {
                if (!moe) { if (PHM(5)) {
                    g8::SchedPlain S{(const char*)(F.ws + WS_H), (const char*)(F.ws + R_WGU), T / 256, 2 * DFF / 256, 1024, G, cb};
                    g8::EpiSwiGLU E{(bf16*)(F.ws + R_ACT), DFF};
                    g8::gemm_phase<g8::EpiSwiGLU, g8::SchedPlain, false>(F.lds, F.tid, 1024, 1024, S, E);
                    convert_experts(F, 1); }
                } else if (PHM(10)) {
                    moe_tables(F, 2 * DEXP / 256);
                    g8::SchedMoE S{(const char*)(F.ws + WS_H), (const char*)(F.ws + WS_WEGU), (size_t)7168 * 1024 * 2, (const int*)(F.ws + WS_ROWL), F.TAB, 2 * DEXP / 256, 1024, G, cb, true, -1};
                    g8::EpiSwiGLU E{(bf16*)(F.ws + R_ACTM), DEXP};
                    g8::gemm_phase<g8::EpiSwiGLU, g8::SchedMoE, true>(F.lds, F.tid, 1024, 1024, S, E);
                }
            } else if (s == 6) {
                if (!moe) { if (PHM(6)) {
                    g8::SchedPlain S{(const char*)(F.ws + R_ACT), (const char*)(F.ws + R_WD), T / 256, 4, DFF, G, cb};
                    g8::EpiF32 E{(float*)(F.ws + R_Y), 1024};
                    g8::gemm_phase<g8::EpiF32, g8::SchedPlain, false>(F.lds, F.tid, DFF, DFF, S, E); }
                } else if (PHM(11)) {
                    moe_tables(F, 4);
                    const int full = __builtin_amdgcn_readfirstlane(F.TAB[33]), sk = __builtin_amdgcn_readfirstlane(F.TAB[35]);
                    { g8::SchedMoE S{(const char*)(F.ws + R_ACTM), (const char*)(F.ws + WS_WED), (size_t)1024 * DEXP * 2, (const int*)(F.ws + WS_ROWL), F.TAB, 4, DEXP, G, cb, false, full};
                      g8::EpiBf16Rows E{(bf16*)(F.ws + WS_WEGU), 1024};
                      g8::gemm_phase<g8::EpiBf16Rows, g8::SchedMoE, false>(F.lds, F.tid, DEXP, DEXP, S, E); }
                    { int t_ = threadIdx.x; asm volatile("" : "+v"(t_)); F.tid = t_; F.lane = t_ & 63; }
                    {
                      g8::SchedMoETail S{(const char*)(F.ws + R_ACTM), (const char*)(F.ws + WS_WED), (size_t)1024 * DEXP * 2, F.TAB, 4, DEXP, F.vcu};
                      g8::EpiSlab E{(bf16*)(F.ws + WS_H)};
                      g8::gemm_phase<g8::EpiSlab, g8::SchedMoETail, false>(F.lds, F.tid, DEXP, DEXP / sk, S, E); }
                }
            } else if (s == 7 && PHM(7)) {
                if (moe) row_phase<2, true, false>(F, l); else row_phase<2, false, true>(F, l);
            }
        }
        if (rep + 1 < nrep) xcd_barrier(bar);
        }
        if (ph + 1 < hi) xcd_barrier(bar);
    }
}

constexpr int N_PHASES = 19;
extern "C" void kernel_launch(void* const* d_in, const int* in_sizes, int n_in, void* d_out, int out_size, void* d_ws, size_t ws_size, hipStream_t stream) {
    static int ready = 0;
    if (ready == 0) {
        if (n_in != 24 || out_size != T * DM || ws_size < WS_END) { fprintf(stderr, "kernel_launch: unexpected problem (n_in %d, out %d, ws %zu < %zu)\n", n_in, out_size, ws_size, (size_t)WS_END); ready = -1; return; }
        if (hipFuncSetAttribute((const void*)mk_fwd, hipFuncAttributeMaxDynamicSharedMemorySize, LDS_BYTES) != hipSuccess) { fprintf(stderr, "kernel_launch: hipFuncSetAttribute failed\n"); ready = -1; return; }
        int per_cu = 0;
        if (hipOccupancyMaxActiveBlocksPerMultiprocessor(&per_cu, (const void*)mk_fwd, NWAVES * 64, LDS_BYTES) != hipSuccess || per_cu < 1) fprintf(stderr, "kernel_launch: occupancy query reports %d\n", per_cu);
        (void)hipGetLastError();
        ready = 1;
    }
    if (ready < 0) return;
    (void)hipMemsetAsync((char*)d_ws + WS_CTL, 0, CTL_ZERO_BYTES, stream);
    Args a{};
    for (int i = 0; i < 24; ++i) a.in[i] = (const float*)d_in[i];
    a.out = (float*)d_out; a.ws = (unsigned char*)d_ws;
#if MK_N_LAUNCHES == 1
    a.ph_lo = 0; a.ph_hi = N_PHASES;
    hipLaunchKernelGGL(mk_fwd, dim3(NBLK), dim3(NWAVES * 64), LDS_BYTES, stream, a);
#else
    for (int p = 0; p < N_PHASES; ++p) { a.ph_lo = p; a.ph_hi = p + 1; hipLaunchKernelGGL(mk_fwd, dim3(NBLK), dim3(NWAVES * 64), LDS_BYTES, stream, a); }
#endif
}
```
